# Optimizing an MI355X kernel written in HIP

```python
import math
import jax, jax.numpy as jnp
from jax import lax
import numpy as np

D_MODEL = 1024
BATCH = 16
SEQ = 2048
DEPTH = 1

CTX_LEN = 256
GRID_W = 64
EPS = 1e-6
ROPE_THETA = 10000.0

DA_HEADS = 4
DA_HD = 64
DA_WIDTH = DA_HEADS * 2 * DA_HD
DA_Q_BLOCK = 128

ML_HEADS = 4
ML_HD = 128
ML_WIDTH = ML_HEADS * ML_HD
ML_CONV = 3
ML_CHUNK = 128
ML_GATES = 4 * ML_HEADS

IN_WIDTHS = (DA_WIDTH, DA_WIDTH, DA_WIDTH, DA_WIDTH,
             ML_WIDTH, ML_WIDTH, ML_WIDTH, ML_WIDTH,
             ML_GATES,
             D_MODEL, D_MODEL)
IN_WIDTH = 4 * DA_WIDTH + 4 * ML_WIDTH + ML_GATES + 2 * D_MODEL

kernel_name = "hybrid_diffattn_mlstm_dit_block"


def rms_norm(x, g):
    xf = x.astype(jnp.float32)
    y = xf * lax.rsqrt(jnp.mean(xf * xf, axis=-1, keepdims=True) + EPS)
    return (y * g.astype(jnp.float32)).astype(x.dtype)


def split_cols(p):
    idx = []
    acc = 0
    for w in IN_WIDTHS[:-1]:
        acc += w
        idx.append(acc)
    return jnp.split(p, idx, axis=-1)


def split_heads(a, h):
    b, t, _ = a.shape
    return a.reshape(b, t, h, -1).transpose(0, 2, 1, 3)


def merge_heads(a):
    b, h, t, d = a.shape
    return a.transpose(0, 2, 1, 3).reshape(b, t, h * d)


def axial_rope_angles(n_tokens):
    rows = n_tokens // GRID_W
    row_id = jnp.repeat(jnp.arange(rows, dtype=jnp.float32), GRID_W)
    col_id = jnp.tile(jnp.arange(GRID_W, dtype=jnp.float32), rows)
    n_freq = DA_HD // 4
    inv_freq = ROPE_THETA ** (-jnp.arange(n_freq, dtype=jnp.float32) / n_freq)
    return row_id[:, None] * inv_freq, col_id[:, None] * inv_freq


def rope_1d(x, ang):
    nf = ang.shape[-1]
    x1, x2 = x[..., :nf], x[..., nf:]
    cos, sin = jnp.cos(ang), jnp.sin(ang)
    return jnp.concatenate([x1 * cos - x2 * sin, x1 * sin + x2 * cos], axis=-1)


def rope_2d(x, ang_r, ang_c):
    xf = x.astype(jnp.float32)
    half = x.shape[-1] // 2
    y = jnp.concatenate([rope_1d(xf[..., :half], ang_r), rope_1d(xf[..., half:], ang_c)], axis=-1)
    return y.astype(x.dtype)


def diff_maps(a, g):
    b, t, _ = a.shape
    a = a.reshape(b, t, DA_HEADS, 2, DA_HD).transpose(3, 0, 2, 1, 4)
    a = rms_norm(a, g)
    return a[0], a[1]


def diff_attend(q1, q2, k1, k2, v, lam):
    scale = DA_HD ** -0.5
    s1 = jnp.einsum('bhqd,bhkd->bhqk', q1, k1, preferred_element_type=jnp.float32) * scale
    s2 = jnp.einsum('bhqd,bhkd->bhqk', q2, k2, preferred_element_type=jnp.float32) * scale
    p = jax.nn.softmax(s1, axis=-1) - lam * jax.nn.softmax(s2, axis=-1)
    return jnp.einsum('bhqk,bhkd->bhqd', p.astype(v.dtype), v)


def diff_attention_branch(qa_c, ka_c, va_c, za_c, qa_l, ka_l, va_l, za_l,
                          q_g, k_g, lam, lam_init, head_g, ang_r, ang_c, need_ctx):
    q1c, q2c = diff_maps(qa_c, q_g)
    k1c, k2c = diff_maps(ka_c, k_g)
    vc = split_heads(va_c, DA_HEADS)
    q1l, q2l = diff_maps(qa_l, q_g)
    k1l, k2l = diff_maps(ka_l, k_g)
    q1l, q2l = rope_2d(q1l, ang_r, ang_c), rope_2d(q2l, ang_r, ang_c)
    k1l, k2l = rope_2d(k1l, ang_r, ang_c), rope_2d(k2l, ang_r, ang_c)
    vl = split_heads(va_l, DA_HEADS)
    k1 = jnp.concatenate([k1c, k1l], axis=2)
    k2 = jnp.concatenate([k2c, k2l], axis=2)
    v = jnp.concatenate([vc, vl], axis=2)
    b, h, n, _ = q1l.shape
    nb = n // DA_Q_BLOCK

    def to_blocks(q):
        return q.reshape(b, h, nb, DA_Q_BLOCK, DA_HD).transpose(2, 0, 1, 3, 4)

    out = lax.map(lambda qs: diff_attend(qs[0], qs[1], k1, k2, v, lam),
                  (to_blocks(q1l), to_blocks(q2l)))
    out = out.transpose(1, 2, 0, 3, 4).reshape(b, h, n, 2 * DA_HD)

    def finish(o, z):
        return merge_heads(rms_norm(o, head_g) * (1.0 - lam_init)) * jax.nn.silu(z)

    y_l = finish(out, za_l)
    y_c = finish(diff_attend(q1c, q2c, k1c, k2c, vc, lam), za_c) if need_ctx else None
    return y_l, y_c


def short_conv(x, w, bias):
    k_w = w.shape[0]
    pad = k_w // 2
    t = x.shape[1]
    xp = jnp.pad(x, ((0, 0), (pad, pad), (0, 0)))
    y = bias + w[0] * xp[:, 0:t]
    for k in range(1, k_w):
        y = y + w[k] * xp[:, k:k + t]
    return y


def mlstm_prepare(xm, vm, gates, conv_w, conv_b, wq, wk, if_bias):
    b, t, _ = xm.shape
    xc = jax.nn.silu(short_conv(xm, conv_w, conv_b))
    xh = split_heads(xc, ML_HEADS)
    q = jnp.einsum('bhtd,hde->bhte', xh, wq).astype(jnp.float32)
    k = (jnp.einsum('bhtd,hde->bhte', xh, wk) * (ML_HD ** -0.5)).astype(jnp.float32)
    v = split_heads(vm, ML_HEADS).astype(jnp.float32)
    g = (gates + if_bias).astype(jnp.float32).reshape(b, t, 2, 2, ML_HEADS)
    g = g.transpose(2, 3, 0, 4, 1)
    ig = g[:, 0]
    lf = jax.nn.log_sigmoid(g[:, 1])
    return xc, q, k, v, ig, lf


def mlstm_chunkwise(q, k, v, ig, lf, state):
    b, h, t, d = q.shape
    nc = t // ML_CHUNK
    tril = jnp.tril(jnp.ones((ML_CHUNK, ML_CHUNK), dtype=bool))

    def chunks(a):
        a = a.reshape((b, h, nc, ML_CHUNK) + a.shape[3:])
        return jnp.moveaxis(a, 2, 0)

    def step(carry, inp):
        c_st, n_st, m_st = carry
        qc, kc, vc, ic, fc = inp
        cum_f = jnp.cumsum(fc, axis=-1)
        log_d = cum_f[..., :, None] - cum_f[..., None, :] + ic[..., None, :]
        log_d = jnp.where(tril, log_d, -jnp.inf)
        m_inter = cum_f + m_st[..., None]
        m_t = jnp.maximum(m_inter, jnp.max(log_d, axis=-1))
        s = jnp.einsum('bhtd,bhsd->bhts', qc, kc) * jnp.exp(log_d - m_t[..., None])
        dec = jnp.exp(m_inter - m_t)
        num = jnp.einsum('bhts,bhsd->bhtd', s, vc) + dec[..., None] * jnp.einsum('bhtk,bhkv->bhtv', qc, c_st)
        den = jnp.sum(s, axis=-1) + dec * jnp.einsum('bhtk,bhk->bht', qc, n_st)
        h_out = num / jnp.maximum(jnp.abs(den), jnp.exp(-m_t))[..., None]
        f_tot = cum_f[..., -1]
        g_s = f_tot[..., None] - cum_f + ic
        m_new = jnp.maximum(f_tot + m_st, jnp.max(g_s, axis=-1))
        w_s = jnp.exp(g_s - m_new[..., None])
        carry_dec = jnp.exp(f_tot + m_st - m_new)
        c_new = carry_dec[..., None, None] * c_st + jnp.einsum('bhs,bhsk,bhsv->bhkv', w_s, kc, vc)
        n_new = carry_dec[..., None] * n_st + jnp.einsum('bhs,bhsk->bhk', w_s, kc)
        return (c_new, n_new, m_new), h_out

    state, hs = lax.scan(step, state, (chunks(q), chunks(k), chunks(v), chunks(ig), chunks(lf)))
    hs = jnp.moveaxis(hs, 0, 2).reshape(b, h, t, d)
    return hs, state


def mlstm_bidirectional(qc, kc, vc, igc, lfc, ql, kl, vl, igl, lfl):
    b, h, _, d = ql.shape
    zero = (jnp.zeros((b, h, d, d), jnp.float32), jnp.zeros((b, h, d), jnp.float32),
            jnp.zeros((b, h), jnp.float32))

    def flip(a):
        return jnp.flip(a, axis=2)

    hc_f, st_f = mlstm_chunkwise(qc, kc, vc, igc[0], lfc[0], zero)
    hl_f, _ = mlstm_chunkwise(ql, kl, vl, igl[0], lfl[0], st_f)
    hc_b, st_b = mlstm_chunkwise(flip(qc), flip(kc), flip(vc), flip(igc[1]), flip(lfc[1]), zero)
    hl_b, _ = mlstm_chunkwise(flip(ql), flip(kl), flip(vl), flip(igl[1]), flip(lfl[1]), st_b)
    return hc_f + flip(hc_b), hl_f + flip(hl_b)


def mlstm_branch(xm_c, vm_c, g_c, zb_c, ob_c, xm_l, vm_l, g_l, zb_l, ob_l,
                 conv_w, conv_b, wq, wk, if_bias, head_g, skip, need_ctx):
    xcv_c, qc, kc, vc, igc, lfc = mlstm_prepare(xm_c, vm_c, g_c, conv_w, conv_b, wq, wk, if_bias)
    xcv_l, ql, kl, vl, igl, lfl = mlstm_prepare(xm_l, vm_l, g_l, conv_w, conv_b, wq, wk, if_bias)
    hc, hl = mlstm_bidirectional(qc, kc, vc, igc, lfc, ql, kl, vl, igl, lfl)
    g_heads = head_g.reshape(ML_HEADS, 1, ML_HD)

    def finish(hh, xcv, z, o):
        hh = merge_heads(rms_norm(hh, g_heads)).astype(z.dtype)
        return (jax.nn.sigmoid(o) * hh + skip * xcv) * jax.nn.silu(z)

    y_l = finish(hl, xcv_l, zb_l, ob_l)
    y_c = finish(hc, xcv_c, zb_c, ob_c) if need_ctx else None
    return y_l, y_c


def setup_inputs(seed: int = 0) -> dict:
    key = jax.random.key(seed)
    ks = jax.random.split(key, 32)
    f32 = jnp.float32
    D, L = D_MODEL, DEPTH

    def nrm(k, shape, scale):
        return jax.random.normal(k, shape, f32) * scale

    i_bias = nrm(ks[8], (L, 2, 1, ML_HEADS), 0.1)
    f_bias = jnp.linspace(3.0, 6.0, ML_HEADS, dtype=f32) + nrm(ks[9], (L, 2, 1, ML_HEADS), 0.1)
    b_if = jnp.concatenate([i_bias, f_bias], axis=2).reshape(L, ML_GATES)
    return {
        "x": nrm(ks[0], (BATCH, SEQ, D), 1.0),
        "c": nrm(ks[1], (BATCH, D), 1.0),
        "ctx": nrm(ks[2], (BATCH, CTX_LEN, D), 1.0),
        "c_ctx": nrm(ks[3], (D,), 1.0),
        "norm_w": 1.0 + nrm(ks[4], (L, D), 0.1),
        "w_mod": nrm(ks[5], (L, D, 3 * D), 0.5 * D ** -0.5),
        "b_mod": nrm(ks[6], (L, 3 * D), 0.02),
        "w_in": nrm(ks[7], (L, D, IN_WIDTH), D ** -0.5),
        "b_if": b_if,
        "da_q_norm": 1.0 + nrm(ks[10], (L, DA_HD), 0.1),
        "da_k_norm": 1.0 + nrm(ks[11], (L, DA_HD), 0.1),
        "da_lambda_q1": nrm(ks[12], (L, DA_HD), 0.1),
        "da_lambda_k1": nrm(ks[13], (L, DA_HD), 0.1),
        "da_lambda_q2": nrm(ks[14], (L, DA_HD), 0.1),
        "da_lambda_k2": nrm(ks[15], (L, DA_HD), 0.1),
        "da_head_norm": 1.0 + nrm(ks[16], (L, 2 * DA_HD), 0.1),
        "w_out_a": nrm(ks[17], (L, DA_WIDTH, D), DA_WIDTH ** -0.5),
        "ml_conv_w": nrm(ks[18], (L, ML_CONV, ML_WIDTH), ML_CONV ** -0.5),
        "ml_conv_b": nrm(ks[19], (L, ML_WIDTH), 0.02),
        "ml_wq": nrm(ks[20], (L, ML_HEADS, ML_HD, ML_HD), ML_HD ** -0.5),
        "ml_wk": nrm(ks[21], (L, ML_HEADS, ML_HD, ML_HD), ML_HD ** -0.5),
        "ml_head_norm": 1.0 + nrm(ks[22], (L, ML_WIDTH), 0.1),
        "ml_skip": 1.0 + nrm(ks[23], (L, ML_WIDTH), 0.1),
        "w_out_b": nrm(ks[24], (L, ML_WIDTH, D), ML_WIDTH ** -0.5),
        "w_o": nrm(ks[25], (L, D, D), D ** -0.5),
    }


def reference(x, c, ctx, c_ctx, norm_w, w_mod, b_mod, w_in, b_if, da_q_norm, da_k_norm,
              da_lambda_q1, da_lambda_k1, da_lambda_q2, da_lambda_k2, da_head_norm, w_out_a,
              ml_conv_w, ml_conv_b, ml_wq, ml_wk, ml_head_norm, ml_skip, w_out_b, w_o):
    n_lat = x.shape[1]
    ang_r, ang_c = axial_rope_angles(n_lat)
    for l in range(DEPTH):
        need_ctx = l < DEPTH - 1
        lam_init = 0.8 - 0.6 * math.exp(-0.3 * l)
        mod_l = jax.nn.silu(c) @ w_mod[l] + b_mod[l]
        mod_c = jax.nn.silu(c_ctx) @ w_mod[l] + b_mod[l]
        sh_l, sc_l, gt_l = jnp.split(mod_l, 3, axis=-1)
        sh_c, sc_c, gt_c = jnp.split(mod_c, 3, axis=-1)
        h_l = rms_norm(x, norm_w[l]) * (1.0 + sc_l[:, None]) + sh_l[:, None]
        h_c = rms_norm(ctx, norm_w[l]) * (1.0 + sc_c) + sh_c
        qa_l, ka_l, va_l, za_l, xm_l, vm_l, zb_l, ob_l, gif_l, ga_l, gb_l = split_cols(h_l @ w_in[l])
        qa_c, ka_c, va_c, za_c, xm_c, vm_c, zb_c, ob_c, gif_c, ga_c, gb_c = split_cols(h_c @ w_in[l])
        lam = (jnp.exp(jnp.sum(da_lambda_q1[l].astype(jnp.float32) * da_lambda_k1[l].astype(jnp.float32)))
               - jnp.exp(jnp.sum(da_lambda_q2[l].astype(jnp.float32) * da_lambda_k2[l].astype(jnp.float32)))
               + lam_init)
        ya_l, ya_c = diff_attention_branch(qa_c, ka_c, va_c, za_c, qa_l, ka_l, va_l, za_l,
                                           da_q_norm[l], da_k_norm[l], lam, lam_init,
                                           da_head_norm[l], ang_r, ang_c, need_ctx)
        yb_l, yb_c = mlstm_branch(xm_c, vm_c, gif_c, zb_c, ob_c, xm_l, vm_l, gif_l, zb_l, ob_l,
                                  ml_conv_w[l], ml_conv_b[l], ml_wq[l], ml_wk[l], b_if[l],
                                  ml_head_norm[l], ml_skip[l], need_ctx)
        y_l = (jax.nn.sigmoid(ga_l) * (ya_l @ w_out_a[l])
               + jax.nn.sigmoid(gb_l) * (yb_l @ w_out_b[l])) @ w_o[l]
        if need_ctx:
            y_c = (jax.nn.sigmoid(ga_c) * (ya_c @ w_out_a[l])
                   + jax.nn.sigmoid(gb_c) * (yb_c @ w_out_b[l])) @ w_o[l]
            ctx = ctx + gt_c * y_c
        x = x + gt_l[:, None] * y_l
    return x
```

```cpp
#include <hip/hip_runtime.h>
#include <cstdio>
#include <cstdint>
#include <cmath>

typedef unsigned short bf16_t;
__device__ __forceinline__ float bf2f(bf16_t v) { return __uint_as_float(((unsigned)v) << 16); }
__device__ __forceinline__ bf16_t f2bf(float f) { unsigned u = __float_as_uint(f); return (bf16_t)((u + 0x7fffu + ((u >> 16) & 1u)) >> 16); }

constexpr int DM = 1024, NB = 16, SEQ = 2048, CTX = 256;
constexpr int R = NB * SEQ;
constexpr int RCX = NB * CTX;
constexpr int RC = R + RCX;
constexpr int INW = 6160;
constexpr int NKEY = CTX + SEQ;
constexpr float EPS = 1e-6f;
constexpr float C2 = 0.125f * 1.4426950408889634f;
constexpr float LAM_INIT = 0.2f;

constexpr size_t MiB = 1u << 20;
constexpr size_t WS_CTL = 0;
constexpr size_t WS_MOD = 1 * MiB;
constexpr size_t WS_ROPE = 1 * MiB + 256 * 1024;
constexpr size_t WS_GATES = 2 * MiB;
constexpr size_t WS_WTIN = 6 * MiB;
constexpr size_t WS_WTOA = 19 * MiB, WS_WTOB = 20 * MiB, WS_WTO = 21 * MiB, WS_MWQ = 23 * MiB;
constexpr size_t WS_H = 24 * MiB;
constexpr size_t WS_HF = 24 * MiB, WS_HB = 56 * MiB;
constexpr size_t WS_Q = 96 * MiB;
constexpr size_t WS_K = 128 * MiB;
constexpr size_t WS_V = 164 * MiB;
constexpr size_t WS_ZA = 200 * MiB;
constexpr size_t WS_XM = 232 * MiB;
constexpr size_t WS_VM = 268 * MiB;
constexpr size_t WS_ZB = 304 * MiB;
constexpr size_t WS_OB = 336 * MiB;
constexpr size_t WS_GA = 368 * MiB;
constexpr size_t WS_GB = 432 * MiB;
constexpr size_t WS_END = 496 * MiB;

struct P {
    const float *x, *c, *ctx, *c_ctx, *norm_w, *w_mod, *b_mod, *w_in, *b_if, *q_g, *k_g, *lq1, *lk1, *lq2, *lk2, *head_g, *w_out_a,
        *conv_w, *conv_b, *wq, *wk, *ml_head_g, *ml_skip, *w_out_b, *w_o;
    float* out; unsigned char* ws;
};

__device__ __forceinline__ float siluf(float v) { return v / (1.f + expf(-v)); }
__device__ __forceinline__ float sigmf(float v) { return 1.f / (1.f + expf(-v)); }
__device__ __forceinline__ float logsigf(float v) { return fminf(v, 0.f) - log1pf(expf(-fabsf(v))); }
__device__ __forceinline__ int jperm(int dd) { return 8 * ((dd & 15) >> 2) + 4 * (dd >> 4) + (dd & 3); }

__global__ void __launch_bounds__(256) n_mod(P p) {
    __shared__ float sc[17][1024];
    __shared__ float red[4][17][64];
    const int tid = threadIdx.x;
    for (int i = tid; i < 17 * 1024; i += 256) { const int b = i >> 10, k = i & 1023; const float v = b < 16 ? p.c[b * 1024 + k] : p.c_ctx[k]; sc[b][k] = siluf(v); }
    __syncthreads();
    const int col = blockIdx.x * 64 + (tid & 63), ks = tid >> 6;
    float acc[17];
#pragma unroll
    for (int b = 0; b < 17; ++b) acc[b] = 0.f;
    for (int k = ks * 256; k < ks * 256 + 256; ++k) { const float w = p.w_mod[(size_t)k * 3072 + col];
#pragma unroll
        for (int b = 0; b < 17; ++b) acc[b] += sc[b][k] * w; }
#pragma unroll
    for (int b = 0; b < 17; ++b) red[ks][b][tid & 63] = acc[b];
    __syncthreads();
    float* mod = (float*)(p.ws + WS_MOD);
    for (int i = tid; i < 17 * 64; i += 256) { const int b = i >> 6, cc = i & 63; const int co = blockIdx.x * 64 + cc;
        mod[b * 3072 + co] = red[0][b][cc] + red[1][b][cc] + red[2][b][cc] + red[3][b][cc] + p.b_mod[co]; }
}
__global__ void n_tables(P p) {
    float* rope = (float*)(p.ws + WS_ROPE);
    const int tid = threadIdx.x;
    for (int i = tid; i < 64 * 16; i += blockDim.x) { const int pos = i >> 4, f = i & 15;
        const float inv = powf(10000.0f, -(float)f / 16.0f); const float a = (float)pos * inv; rope[i] = cosf(a); rope[1024 + i] = sinf(a); }
    if (tid == 0) { float s1 = 0.f, s2 = 0.f; for (int i = 0; i < 64; ++i) { s1 += p.lq1[i] * p.lk1[i]; s2 += p.lq2[i] * p.lk2[i]; }
        rope[2048] = expf(s1) - expf(s2) + LAM_INIT; }
}
__global__ void __launch_bounds__(256) n_hnorm(P p) {
    const int row = blockIdx.x * 4 + (threadIdx.x >> 6), lane = threadIdx.x & 63;
    const float* xr; int b;
    if (row < R) { xr = p.x + (size_t)row * 1024; b = row / SEQ; } else { xr = p.ctx + (size_t)(row - R) * 1024; b = 16; }
    const float* mod = (const float*)(p.ws + WS_MOD) + b * 3072;
    float v[16]; float ss = 0.f;
#pragma unroll
    for (int j = 0; j < 16; ++j) { v[j] = xr[lane + 64 * j]; ss += v[j] * v[j]; }
#pragma unroll
    for (int o = 1; o < 64; o <<= 1) ss += __shfl_xor(ss, o);
    const float r = rsqrtf(ss * (1.f / 1024.f) + EPS);
    bf16_t* H = (bf16_t*)(p.ws + WS_H) + (size_t)row * 1024;
#pragma unroll
    for (int j = 0; j < 16; ++j) { const int k = lane + 64 * j; const float y = v[j] * r * p.norm_w[k]; H[k] = f2bf(y * (1.f + mod[1024 + k]) + mod[k]); }
}
template <class F> __global__ void __launch_bounds__(256) n_gemm(const bf16_t* A, int lda, const float* B, int ldb, int bcol0, int K, int row0, F f) {
    __shared__ float As[16][65];
    __shared__ float Bs[16][65];
    __shared__ float Cs[64][65];
    const int tid = threadIdx.x, tx = tid & 15, ty = tid >> 4;
    const int rbase = row0 + blockIdx.y * 64, cbase = blockIdx.x * 64;
    float acc[4][4];
#pragma unroll
    for (int i = 0; i < 4; ++i)
#pragma unroll
        for (int j = 0; j < 4; ++j) acc[i][j] = 0.f;
    for (int k0 = 0; k0 < K; k0 += 16) {
        for (int i = tid; i < 64 * 16; i += 256) { const int r = i >> 4, kk = i & 15; As[kk][r] = bf2f(A[(size_t)(rbase + r) * lda + k0 + kk]); }
        for (int i = tid; i < 16 * 64; i += 256) { const int kk = i >> 6, cc = i & 63; Bs[kk][cc] = B[(size_t)(k0 + kk) * ldb + bcol0 + cbase + cc]; }
        __syncthreads();
#pragma unroll
        for (int kk = 0; kk < 16; ++kk) { float a[4], b[4];
#pragma unroll
            for (int i = 0; i < 4; ++i) { a[i] = As[kk][ty * 4 + i]; b[i] = Bs[kk][tx * 4 + i]; }
#pragma unroll
            for (int i = 0; i < 4; ++i)
#pragma unroll
                for (int j = 0; j < 4; ++j) acc[i][j] += a[i] * b[j]; }
        __syncthreads();
    }
#pragma unroll
    for (int i = 0; i < 4; ++i)
#pragma unroll
        for (int j = 0; j < 4; ++j) Cs[ty * 4 + i][tx * 4 + j] = acc[i][j];
    __syncthreads();
    f(Cs, rbase, cbase, tid);
}
struct EpiPlain { bf16_t* dst; int ldd; int mode;
    __device__ void operator()(float (*Cs)[65], int rbase, int cbase, int tid) const {
        const int r = tid >> 2, c0 = (tid & 3) * 16;
        for (int i = 0; i < 16; ++i) { float v = Cs[r][c0 + i]; if (mode == 1) v = siluf(v); else if (mode == 2) v = sigmf(v); dst[(size_t)(rbase + r) * ldd + cbase + c0 + i] = f2bf(v); } } };
struct EpiQK { bf16_t* dst; const float* g; const float* rope; float scale;
    __device__ void operator()(float (*Cs)[65], int rbase, int cbase, int tid) const {
        const int r = tid >> 2, c0 = (tid & 3) * 16; const int row = rbase + r;
        float ss = 0.f; for (int i = 0; i < 16; ++i) { const float v = Cs[r][c0 + i]; ss += v * v; }
        ss += __shfl_xor(ss, 1); ss += __shfl_xor(ss, 2);
        const float rn = rsqrtf(ss * (1.f / 64.f) + EPS);
        __syncthreads();
        for (int i = 0; i < 16; ++i) Cs[r][c0 + i] = Cs[r][c0 + i] * rn * g[c0 + i];
        __syncthreads();
        const bool lat = row < R; const int t = row % SEQ; const int rid = t >> 6, cid = t & 63;
        for (int i = 0; i < 16; ++i) { const int d = c0 + i, blk = d >> 5, dd = d & 31, f = dd & 15; float v;
            if (lat) { const int pos = blk ? cid : rid; const float cs = rope[pos * 16 + f], sn = rope[1024 + pos * 16 + f];
                const float x1 = Cs[r][blk * 32 + f], x2 = Cs[r][blk * 32 + 16 + f]; v = dd < 16 ? x1 * cs - x2 * sn : x1 * sn + x2 * cs; }
            else v = Cs[r][d];
            dst[(size_t)row * 512 + cbase + blk * 32 + jperm(dd)] = f2bf(v * scale); } } };
__global__ void __launch_bounds__(256) n_gates(P p) {
    const int idx = blockIdx.x * 256 + threadIdx.x; const int row = idx >> 4, g = idx & 15;
    const bf16_t* h = (const bf16_t*)(p.ws + WS_H) + (size_t)row * 1024;
    float s = 0.f; for (int k = 0; k < 1024; ++k) s += bf2f(h[k]) * p.w_in[(size_t)k * INW + 4096 + g];
    s += p.b_if[g]; if ((g >> 2) & 1) s = logsigf(s);
    ((float*)(p.ws + WS_GATES))[idx] = s;
}
__device__ __forceinline__ float block_max(float v, float* red) { const int tid = threadIdx.x;
#pragma unroll
    for (int o = 1; o < 64; o <<= 1) v = fmaxf(v, __shfl_xor(v, o));
    __syncthreads(); if ((tid & 63) == 0) red[tid >> 6] = v; __syncthreads(); return fmaxf(fmaxf(red[0], red[1]), fmaxf(red[2], red[3])); }
__device__ __forceinline__ float block_sum(float v, float* red) { const int tid = threadIdx.x;
#pragma unroll
    for (int o = 1; o < 64; o <<= 1) v += __shfl_xor(v, o);
    __syncthreads(); if ((tid & 63) == 0) red[tid >> 6] = v; __syncthreads(); return (red[0] + red[1]) + (red[2] + red[3]); }
__global__ void __launch_bounds__(256) n_attn(P p) {
    __shared__ float q[128]; __shared__ float s1[NKEY]; __shared__ float s2[NKEY]; __shared__ float red[4]; __shared__ float o[128];
    const int tid = threadIdx.x; const int qi = blockIdx.x % SEQ, h = (blockIdx.x / SEQ) & 3, b = blockIdx.x / (SEQ * 4);
    bf16_t* Q = (bf16_t*)(p.ws + WS_Q); const bf16_t* Kb = (const bf16_t*)(p.ws + WS_K); const bf16_t* Vb = (const bf16_t*)(p.ws + WS_V);
    const size_t qrow = (size_t)b * SEQ + qi;
    if (tid < 128) q[tid] = bf2f(Q[qrow * 512 + h * 128 + tid]);
    __syncthreads();
    float m1 = -1e30f, m2 = -1e30f;
    for (int kk = tid; kk < NKEY; kk += 256) { const size_t krow = kk < CTX ? (size_t)R + b * CTX + kk : (size_t)b * SEQ + (kk - CTX);
        const bf16_t* kr = Kb + krow * 512 + h * 128; float a1 = 0.f, a2 = 0.f;
        for (int d = 0; d < 64; ++d) { a1 += q[d] * bf2f(kr[d]); a2 += q[64 + d] * bf2f(kr[64 + d]); }
        s1[kk] = a1; s2[kk] = a2; m1 = fmaxf(m1, a1); m2 = fmaxf(m2, a2); }
    m1 = block_max(m1, red); m2 = block_max(m2, red);
    float l1 = 0.f, l2 = 0.f;
    for (int kk = tid; kk < NKEY; kk += 256) { const float e1 = exp2f(s1[kk] - m1), e2 = exp2f(s2[kk] - m2); s1[kk] = e1; s2[kk] = e2; l1 += e1; l2 += e2; }
    l1 = block_sum(l1, red); l2 = block_sum(l2, red);
    const float lam = ((const float*)(p.ws + WS_ROPE))[2048];
    const float i1 = 1.f / l1, i2 = lam / l2;
    __syncthreads();
    for (int kk = tid; kk < NKEY; kk += 256) s1[kk] = s1[kk] * i1 - s2[kk] * i2;
    __syncthreads();
    float ss = 0.f;
    if (tid < 128) { float acc = 0.f;
        for (int kk = 0; kk < NKEY; ++kk) { const size_t krow = kk < CTX ? (size_t)R + b * CTX + kk : (size_t)b * SEQ + (kk - CTX); acc += s1[kk] * bf2f(Vb[krow * 512 + h * 128 + tid]); }
        o[tid] = acc; ss = acc * acc; }
    ss = block_sum(ss, red);
    const float rn = rsqrtf(ss * (1.f / 128.f) + EPS);
    if (tid < 128) { const float za = bf2f(((const bf16_t*)(p.ws + WS_ZA))[qrow * 512 + h * 128 + tid]);
        Q[qrow * 512 + h * 128 + tid] = f2bf(o[tid] * rn * p.head_g[tid] * (1.f - LAM_INIT) * za); }
}
__global__ void __launch_bounds__(256) n_mlstm(P p) {
    extern __shared__ float sm[];
    float* wq = sm;
    float* wk = sm + 16384;
    float* xc = sm + 32768;
    float* qv = xc + 128; float* kv = qv + 128; float* hp = kv + 128  ; float* red = hp + 256;
    const int tid = threadIdx.x; const int dir = blockIdx.x & 1, h = (blockIdx.x >> 1) & 3, b = blockIdx.x >> 3;
    for (int i = tid; i < 16384; i += 256) { wq[i] = p.wq[h * 16384 + i]; wk[i] = p.wk[h * 16384 + i]; }
    const bf16_t* XM = (const bf16_t*)(p.ws + WS_XM); const bf16_t* VM = (const bf16_t*)(p.ws + WS_VM); const float* G = (const float*)(p.ws + WS_GATES);
    bf16_t* HO = (bf16_t*)(p.ws + (dir ? WS_HB : WS_HF));
    const int dv = tid & 127, kh = tid >> 7;
    float C[64];
#pragma unroll
    for (int i = 0; i < 64; ++i) C[i] = 0.f;
    float nst = 0.f;
    float m = 0.f;
    const float cw0 = p.conv_w[0 * 512 + h * 128 + dv], cw1 = p.conv_w[1 * 512 + h * 128 + dv], cw2 = p.conv_w[2 * 512 + h * 128 + dv], cb = p.conv_b[h * 128 + dv];
    __syncthreads();
    for (int seg = 0; seg < 2; ++seg) {
        const int L = seg == 0 ? CTX : SEQ; const size_t rbase = seg == 0 ? (size_t)R + b * CTX : (size_t)b * SEQ;
        for (int st = 0; st < L; ++st) { const int t = dir ? L - 1 - st : st; const size_t row = rbase + t;
            if (tid < 128) { float a = cb + cw1 * bf2f(XM[row * 512 + h * 128 + dv]);
                if (t > 0) a += cw0 * bf2f(XM[(row - 1) * 512 + h * 128 + dv]);
                if (t < L - 1) a += cw2 * bf2f(XM[(row + 1) * 512 + h * 128 + dv]);
                xc[dv] = siluf(a); }
            __syncthreads();
            {
                const float* w = kh ? wk : wq; float a = 0.f;
                for (int d = 0; d < 128; ++d) a += xc[d] * w[d * 128 + dv];
                if (kh) kv[dv] = a * 0.08838834764831845f; else qv[dv] = a; }
            const float ig = G[row * 16 + dir * 8 + h], lf = G[row * 16 + dir * 8 + 4 + h];
            const float mn = fmaxf(lf + m, ig); const float a = expf(lf + m - mn), bb = expf(ig - mn); m = mn;
            const float vv = bf2f(VM[row * 512 + h * 128 + dv]);
            __syncthreads();
            float part = 0.f;
#pragma unroll
            for (int i = 0; i < 64; ++i) { const int dk = kh * 64 + i; C[i] = a * C[i] + bb * kv[dk] * vv; part += qv[dk] * C[i]; }
            hp[kh * 128 + dv] = part;
            float dn = 0.f;
            if (tid < 128) { nst = a * nst + bb * kv[tid]; dn = qv[tid] * nst; }
#pragma unroll
            for (int o = 1; o < 64; o <<= 1) dn += __shfl_xor(dn, o);
            if ((tid & 63) == 0) red[tid >> 6] = dn;
            __syncthreads();
            if (seg == 1 && tid < 128) { const float den = red[0] + red[1]; const float num = hp[dv] + hp[128 + dv];
                HO[row * 512 + h * 128 + dv] = f2bf(num / fmaxf(fabsf(den), expf(-m))); }
            __syncthreads();
        }
    }
}
__global__ void __launch_bounds__(512) n_finish(P p) {
    __shared__ float red[8];
    const int row = blockIdx.x, tid = threadIdx.x, h = tid >> 7; const int t = row % SEQ;
    const bf16_t* HF = (const bf16_t*)(p.ws + WS_HF); const bf16_t* HB = (const bf16_t*)(p.ws + WS_HB); const bf16_t* XM = (const bf16_t*)(p.ws + WS_XM);
    const size_t o = (size_t)row * 512 + tid;
    const float hl = bf2f(HF[o]) + bf2f(HB[o]);
    float ss = hl * hl;
#pragma unroll
    for (int of = 1; of < 64; of <<= 1) ss += __shfl_xor(ss, of);
    if ((tid & 63) == 0) red[tid >> 6] = ss;
    __syncthreads();
    const float rn = rsqrtf((red[2 * h] + red[2 * h + 1]) * (1.f / 128.f) + EPS);
    const float hh = hl * rn * p.ml_head_g[tid];
    float a = p.conv_b[tid] + p.conv_w[512 + tid] * bf2f(XM[o]);
    if (t > 0) a += p.conv_w[tid] * bf2f(XM[o - 512]);
    if (t < SEQ - 1) a += p.conv_w[1024 + tid] * bf2f(XM[o + 512]);
    const float xcv = siluf(a);
    const float ob = bf2f(((const bf16_t*)(p.ws + WS_OB))[o]), zb = bf2f(((const bf16_t*)(p.ws + WS_ZB))[o]);
    ((bf16_t*)(p.ws + WS_K))[o] = f2bf((ob * hh + p.ml_skip[tid] * xcv) * zb);
}
struct EpiGateMul { bf16_t* gate; const bf16_t* add;
    __device__ void operator()(float (*Cs)[65], int rbase, int cbase, int tid) const {
        const int r = tid >> 2, c0 = (tid & 3) * 16;
        for (int i = 0; i < 16; ++i) { const size_t o = (size_t)(rbase + r) * 1024 + cbase + c0 + i; float v = bf2f(gate[o]) * Cs[r][c0 + i]; if (add) v += bf2f(add[o]); gate[o] = f2bf(v); } } };
struct EpiOut { const float* x; const float* mod; float* out;
    __device__ void operator()(float (*Cs)[65], int rbase, int cbase, int tid) const {
        const int r = tid >> 2, c0 = (tid & 3) * 16; const int row = rbase + r, b = row / SEQ;
        for (int i = 0; i < 16; ++i) { const int cc = cbase + c0 + i; const size_t o = (size_t)row * 1024 + cc; out[o] = x[o] + mod[b * 3072 + 2048 + cc] * Cs[r][c0 + i]; } } };

extern "C" void kernel_launch(void* const* d_in, const int* in_sizes, int n_in, void* d_out, int out_size, void* d_ws, size_t ws_size, hipStream_t stream) {
    if (n_in != 25 || ws_size < WS_END) { fprintf(stderr, "kernel_launch: bad args n_in %d ws %zu\n", n_in, ws_size); return; }
    P p{};
    const float** pp = (const float**)&p;
    for (int i = 0; i < 25; ++i) pp[i] = (const float*)d_in[i];
    p.out = (float*)d_out; p.ws = (unsigned char*)d_ws;
    unsigned char* ws = p.ws;
    bf16_t* H = (bf16_t*)(ws + WS_H);
    n_mod<<<48, 256, 0, stream>>>(p);
    n_tables<<<1, 256, 0, stream>>>(p);
    n_hnorm<<<RC / 4, 256, 0, stream>>>(p);
    const float* rope = (const float*)(ws + WS_ROPE);
    n_gemm<EpiQK><<<dim3(8, R / 64), 256, 0, stream>>>(H, 1024, p.w_in, INW, 0, 1024, 0, EpiQK{(bf16_t*)(ws + WS_Q), p.q_g, rope, C2});
    n_gemm<EpiQK><<<dim3(8, RC / 64), 256, 0, stream>>>(H, 1024, p.w_in, INW, 512, 1024, 0, EpiQK{(bf16_t*)(ws + WS_K), p.k_g, rope, 1.f});
    n_gemm<EpiPlain><<<dim3(8, RC / 64), 256, 0, stream>>>(H, 1024, p.w_in, INW, 1024, 1024, 0, EpiPlain{(bf16_t*)(ws + WS_V), 512, 0});
    n_gemm<EpiPlain><<<dim3(8, R / 64), 256, 0, stream>>>(H, 1024, p.w_in, INW, 1536, 1024, 0, EpiPlain{(bf16_t*)(ws + WS_ZA), 512, 1});
    n_gemm<EpiPlain><<<dim3(8, RC / 64), 256, 0, stream>>>(H, 1024, p.w_in, INW, 2048, 1024, 0, EpiPlain{(bf16_t*)(ws + WS_XM), 512, 0});
    n_gemm<EpiPlain><<<dim3(8, RC / 64), 256, 0, stream>>>(H, 1024, p.w_in, INW, 2560, 1024, 0, EpiPlain{(bf16_t*)(ws + WS_VM), 512, 0});
    n_gemm<EpiPlain><<<dim3(8, R / 64), 256, 0, stream>>>(H, 1024, p.w_in, INW, 3072, 1024, 0, EpiPlain{(bf16_t*)(ws + WS_ZB), 512, 1});
    n_gemm<EpiPlain><<<dim3(8, R / 64), 256, 0, stream>>>(H, 1024, p.w_in, INW, 3584, 1024, 0, EpiPlain{(bf16_t*)(ws + WS_OB), 512, 2});
    n_gemm<EpiPlain><<<dim3(16, R / 64), 256, 0, stream>>>(H, 1024, p.w_in, INW, 4112, 1024, 0, EpiPlain{(bf16_t*)(ws + WS_GA), 1024, 2});
    n_gemm<EpiPlain><<<dim3(16, R / 64), 256, 0, stream>>>(H, 1024, p.w_in, INW, 5136, 1024, 0, EpiPlain{(bf16_t*)(ws + WS_GB), 1024, 2});
    n_gates<<<RC * 16 / 256, 256, 0, stream>>>(p);
    n_attn<<<NB * 4 * SEQ, 256, 0, stream>>>(p);
    {
        static bool attr = false;
        if (!attr) { hipFuncSetAttribute((const void*)n_mlstm, hipFuncAttributeMaxDynamicSharedMemorySize, 140 * 1024); attr = true; }
        n_mlstm<<<NB * 4 * 2, 256, (32768 + 128 * 3 + 256 + 8) * 4, stream>>>(p);
    }
    n_finish<<<R, 512, 0, stream>>>(p);
    n_gemm<EpiGateMul><<<dim3(16, R / 64), 256, 0, stream>>>((const bf16_t*)(ws + WS_Q), 512, p.w_out_a, 1024, 0, 512, 0, EpiGateMul{(bf16_t*)(ws + WS_GA), nullptr});
    n_gemm<EpiGateMul><<<dim3(16, R / 64), 256, 0, stream>>>((const bf16_t*)(ws + WS_K), 512, p.w_out_b, 1024, 0, 512, 0, EpiGateMul{(bf16_t*)(ws + WS_GB), (const bf16_t*)(ws + WS_GA)});
    n_gemm<EpiOut><<<dim3(16, R / 64), 256, 0, stream>>>((const bf16_t*)(ws + WS_GB), 1024, p.w_o, 1024, 0, 1024, 0, EpiOut{p.x, (const float*)(ws + WS_MOD), p.out});
}
```

```cpp
#include <hip/hip_runtime.h>
#include <cstdio>
#include <cstdint>
#include <cmath>

#ifndef PROBE_DUP
#define PROBE_DUP 0
#endif
typedef unsigned short bf16_t;
__device__ __forceinline__ float bf2f(bf16_t v) { return __uint_as_float(((unsigned)v) << 16); }
__device__ __forceinline__ bf16_t f2bf(float f) { unsigned u = __float_as_uint(f); return (bf16_t)((u + 0x7fffu + ((u >> 16) & 1u)) >> 16); }

constexpr int DM = 1024, NB = 16, SEQ = 2048, CTX = 256;
constexpr int R = NB * SEQ;
constexpr int RCX = NB * CTX;
constexpr int RC = R + RCX;
constexpr int INW = 6160;
constexpr int NKEY = CTX + SEQ;
constexpr float EPS = 1e-6f;
constexpr float C2 = 0.125f * 1.4426950408889634f;
constexpr float LAM_INIT = 0.2f;

constexpr size_t MiB = 1u << 20;
constexpr size_t WS_CTL = 0;
constexpr size_t WS_MOD = 1 * MiB;
constexpr size_t WS_ROPE = 1 * MiB + 256 * 1024;
constexpr size_t WS_GATES = 2 * MiB;
constexpr size_t WS_WTIN = 6 * MiB;
constexpr size_t WS_WTOA = 19 * MiB, WS_WTOB = 20 * MiB, WS_WTO = 21 * MiB, WS_MWQ = 23 * MiB;
constexpr size_t WS_H = 24 * MiB;
constexpr size_t WS_MQ = 24 * MiB, WS_MK = 60 * MiB;
constexpr size_t WS_Q = 96 * MiB;
constexpr size_t WS_K = 128 * MiB;
constexpr size_t WS_V = 164 * MiB;
constexpr size_t WS_HF = WS_K, WS_HB = WS_V;
constexpr size_t WS_ZA = 200 * MiB;
constexpr size_t WS_YB = WS_ZA;
constexpr size_t WS_XM = 232 * MiB;
constexpr size_t WS_VM = 268 * MiB;
constexpr size_t WS_ZB = 304 * MiB;
constexpr size_t WS_OB = 336 * MiB;
constexpr size_t WS_GA = 368 * MiB;
constexpr size_t WS_GB = 432 * MiB;
constexpr size_t WS_END = 496 * MiB;

struct P {
    const float *x, *c, *ctx, *c_ctx, *norm_w, *w_mod, *b_mod, *w_in, *b_if, *q_g, *k_g, *lq1, *lk1, *lq2, *lk2, *head_g, *w_out_a,
        *conv_w, *conv_b, *wq, *wk, *ml_head_g, *ml_skip, *w_out_b, *w_o;
    float* out; unsigned char* ws;
};

__device__ __forceinline__ float siluf(float v) { return v / (1.f + expf(-v)); }
__device__ __forceinline__ float sigmf(float v) { return 1.f / (1.f + expf(-v)); }
__device__ __forceinline__ float logsigf(float v) { return fminf(v, 0.f) - log1pf(expf(-fabsf(v))); }
__device__ __forceinline__ int jperm(int dd) { return 8 * ((dd & 15) >> 2) + 4 * (dd >> 4) + (dd & 3); }


namespace pg8 {
#define PG8_LAS __attribute__((address_space(3)))
typedef unsigned short bf16_t;
typedef short bf16x8 __attribute__((ext_vector_type(8)));
typedef float f32x4 __attribute__((ext_vector_type(4)));
typedef unsigned u32x4 __attribute__((ext_vector_type(4)));
constexpr int BM = 256, BK = 64, HALF = 128, HTB = HALF * BK * 2  , STAGE_BYTES = 8 * HTB, NXCD = 8, WGM = 8;

__host__ __device__ __forceinline__ int lds_byte(int r, int c) { const int st = (r >> 4) * 2 + (c >> 5), rr = r & 15, cc = c & 31, ob = rr * 64 + cc * 2; return st * 1024 + (ob ^ (((ob >> 9) & 1) << 5)); }
__host__ __device__ __forceinline__ void stage_rc(int b, int& R, int& C) { const int st = b / 1024, sb = b % 1024, swz = sb ^ (((sb >> 9) & 1) << 5); R = (st >> 1) * 16 + swz / 64; C = (st & 1) * 32 + (swz % 64) / 2; }
__host__ __device__ __forceinline__ int perm32(int rho) { const int n = rho >> 4, i = rho & 15; return 8 * (i >> 2) + 4 * n + (i & 3); }

struct Unit { int pm, pn, sel; };
struct Gemm { const bf16_t* A0; const bf16_t* B0; const bf16_t* A1; const bf16_t* B1; int K; };

struct StaticOrder {
    int nM, nN, nwg, G, c;
    __host__ __device__ void init(int M, int N, int G_, int c_) { nM = M / BM; nN = N / BM; nwg = nM * nN; G = G_; c = c_; }
    __host__ __device__ __forceinline__ bool next(int i, Unit& u) const {
        const long L = (long)i * G + c; const bool ok = L < nwg;
        int wgid = ok ? (int)L : 0; { const int q = nwg / NXCD, r = nwg % NXCD, xcd = wgid % NXCD, off = wgid / NXCD; wgid = (xcd < r ? xcd * (q + 1) : r * (q + 1) + (xcd - r) * q) + off; }
        const int nig = WGM * nN, gid = wgid / nig, fm = gid * WGM, gsz = (nM - fm) < WGM ? (nM - fm) : WGM;
        u.pm = fm + ((wgid % nig) % gsz); u.pn = (wgid % nig) / gsz; u.sel = 0; return ok;
    }
    __device__ __forceinline__ void a_ready(const Unit&) const {}
    __device__ __forceinline__ void done(const Unit&) const {}
};

__device__ __forceinline__ unsigned cvt_pk_bf16(float lo, float hi) { unsigned r; asm volatile("v_cvt_pk_bf16_f32 %0, %1, %2" : "=v"(r) : "v"(lo), "v"(hi)); return r; }
template <class Epi, class Sched, bool ALIGN_EPI = false, bool SP2 = false>
__device__ __forceinline__ void gemm_phase(PG8_LAS unsigned char* lds, const Gemm g, const Sched& S, const Epi& E) {
    const int tid = threadIdx.x, wid = __builtin_amdgcn_readfirstlane(tid >> 6), lane = tid & 63, wr = wid >> 2, wc = wid & 3, fr = lane & 15, fq = lane >> 4;
    const int K = g.K, nt = K / BK;
    unsigned voffA[2], voffB[2];
#pragma unroll
    for (int i = 0; i < 2; ++i) { int R, C; stage_rc(tid * 16 + i * 8192, R, C); const int Rb = Epi::PERM ? ((R & ~31) + perm32(R & 31)) : R;
        voffA[i] = (unsigned)(R * K + C) * 2u; voffB[i] = (unsigned)(Rb * K + C) * 2u; }
    const size_t kstep = (size_t)(BK * 2);
    const size_t hstep = (size_t)HALF * K * 2;
    const size_t tstep = 2 * hstep;
    const unsigned ldsw = (unsigned)wid * 1024u;
    const int aoff = lds_byte(wr * 64 + fr, fq * 8), boff = lds_byte(wc * 32 + fr, fq * 8);
#define PG8_SA(b, h) (((b) * 2 + (h)) * HTB)
#define PG8_SB(b, h) ((4 + (b) * 2 + (h)) * HTB)
#define PG8_STAGE(bufoff, gbase, voff) do { _Pragma("unroll") for (int _i = 0; _i < 2; ++_i) \
        __builtin_amdgcn_global_load_lds((const unsigned*)((const char*)(gbase) + (voff)[_i]), (PG8_LAS unsigned*)(lds + (bufoff) + ldsw + _i * 8192), 16, 0, 0); } while (0)
#define PG8_LDA(dst, b, h) do { _Pragma("unroll") for (int m = 0; m < 4; ++m) _Pragma("unroll") for (int k = 0; k < 2; ++k) dst[m][k] = *(const PG8_LAS bf16x8*)(lds + PG8_SA(b, h) + aoff + m * 2048 + k * 1024); } while (0)
#define PG8_LDB(dst, b, h) do { _Pragma("unroll") for (int n = 0; n < 2; ++n) _Pragma("unroll") for (int k = 0; k < 2; ++k) dst[n][k] = *(const PG8_LAS bf16x8*)(lds + PG8_SB(b, h) + boff + n * 2048 + k * 1024); } while (0)
#define PG8_MMA(ai, bj, At, Bt) do { __builtin_amdgcn_s_setprio(1); _Pragma("unroll") for (int m = 0; m < 4; ++m) _Pragma("unroll") for (int n = 0; n < 2; ++n) _Pragma("unroll") for (int k = 0; k < 2; ++k) \
        acc[ai][bj][m][n] = __builtin_amdgcn_mfma_f32_16x16x32_bf16(Bt[n][k], At[m][k], acc[ai][bj][m][n], 0, 0, 0); __builtin_amdgcn_s_setprio(0); } while (0)
#define PG8_WAIT_V(n) asm volatile("s_waitcnt vmcnt(" #n ")" ::: "memory")
#define PG8_WAIT_L(n) asm volatile("s_waitcnt lgkmcnt(" #n ")" ::: "memory")
#define PG8_BAR __builtin_amdgcn_s_barrier()
#define PG8_SCHED __builtin_amdgcn_sched_barrier(0)
    Unit cur, nxt; int ui = 0;
    if (!S.next(0, cur)) return;
    f32x4 acc[2][2][4][2];
#pragma unroll
    for (int a = 0; a < 2; ++a)
#pragma unroll
        for (int b = 0; b < 2; ++b)
#pragma unroll
            for (int m = 0; m < 4; ++m)
#pragma unroll
                for (int n = 0; n < 2; ++n) acc[a][b][m][n] = (f32x4){0.f, 0.f, 0.f, 0.f};
    bf16x8 At[4][2], B0[2][2], B1[2][2];
    const char* cA = (const char*)((cur.sel & 1) ? g.A1 : g.A0) + (size_t)cur.pm * tstep; const char* cB = (const char*)((cur.sel & 1) ? g.B1 : g.B0) + (size_t)cur.pn * tstep;
    S.a_ready(cur);
    if constexpr (SP2) {
        PG8_STAGE(PG8_SB(0, 0), cB, voffB); PG8_STAGE(PG8_SB(0, 1), cB + hstep, voffB); PG8_STAGE(PG8_SA(0, 0), cA, voffA); PG8_STAGE(PG8_SA(0, 1), cA + hstep, voffA);
        if (wr == 1) PG8_BAR;
        PG8_WAIT_V(2); PG8_BAR;
        PG8_STAGE(PG8_SB(1, 0), cB + kstep, voffB); PG8_STAGE(PG8_SA(1, 0), cA + kstep, voffA); PG8_STAGE(PG8_SB(1, 1), cB + hstep + kstep, voffB);
        PG8_WAIT_V(6); PG8_BAR;
    } else {
        PG8_STAGE(PG8_SB(0, 0), cB, voffB); PG8_STAGE(PG8_SA(0, 0), cA, voffA); PG8_STAGE(PG8_SB(0, 1), cB + hstep, voffB); PG8_STAGE(PG8_SA(0, 1), cA + hstep, voffA);
        if (wr == 1) PG8_BAR;
        PG8_WAIT_V(4); PG8_BAR;
        PG8_STAGE(PG8_SB(1, 0), cB + kstep, voffB); PG8_STAGE(PG8_SA(1, 0), cA + kstep, voffA); PG8_STAGE(PG8_SB(1, 1), cB + hstep + kstep, voffB);
        PG8_WAIT_V(6); PG8_BAR;
    }
    for (;;) {
        const bool has_next = S.next(ui + 1, nxt);
        const char* nA = has_next ? (const char*)((nxt.sel & 1) ? g.A1 : g.A0) + (size_t)nxt.pm * tstep : cA; const char* nB = has_next ? (const char*)((nxt.sel & 1) ? g.B1 : g.B0) + (size_t)nxt.pn * tstep : cB;
        for (int t = 0; t < nt; t += 2) {
            const bool last = (t == nt - 2);
            const char* a1 = cA + (size_t)(t + 1) * kstep;
            const char* a2 = last ? nA : cA + (size_t)(t + 2) * kstep; const char* b2 = last ? nB : cB + (size_t)(t + 2) * kstep;
            const char* a3 = a2 + kstep; const char* b3 = b2 + kstep;
            if (last && has_next) S.a_ready(nxt);
            if constexpr (SP2) {
            PG8_LDB(B0, 0, 0); PG8_LDB(B1, 0, 1); PG8_SCHED; PG8_LDA(At, 0, 0); PG8_STAGE(PG8_SA(1, 1), a1 + hstep, voffA);
            PG8_WAIT_V(8); PG8_WAIT_L(0); PG8_BAR; PG8_MMA(0, 0, At, B0); PG8_MMA(0, 1, At, B1); PG8_BAR; PG8_SCHED;
            PG8_LDA(At, 0, 1); PG8_STAGE(PG8_SB(0, 0), b2, voffB); PG8_STAGE(PG8_SB(0, 1), b2 + hstep, voffB); PG8_STAGE(PG8_SA(0, 0), a2, voffA);
            PG8_WAIT_V(8); PG8_WAIT_L(0); PG8_BAR; PG8_MMA(1, 0, At, B0); PG8_MMA(1, 1, At, B1); PG8_BAR; PG8_SCHED;
            PG8_LDB(B0, 1, 0); PG8_LDB(B1, 1, 1); PG8_SCHED; PG8_LDA(At, 1, 0); PG8_STAGE(PG8_SA(0, 1), a2 + hstep, voffA);
            PG8_WAIT_V(8); PG8_WAIT_L(0); PG8_BAR; PG8_MMA(0, 0, At, B0); PG8_MMA(0, 1, At, B1); PG8_BAR; PG8_SCHED;
            PG8_LDA(At, 1, 1); PG8_STAGE(PG8_SB(1, 0), b3, voffB); PG8_STAGE(PG8_SB(1, 1), b3 + hstep, voffB); PG8_STAGE(PG8_SA(1, 0), a3, voffA);
            PG8_WAIT_V(8); PG8_WAIT_L(0); PG8_BAR; PG8_MMA(1, 0, At, B0); PG8_MMA(1, 1, At, B1); PG8_BAR; PG8_SCHED;
            } else {
            PG8_LDB(B0, 0, 0); PG8_SCHED; PG8_LDA(At, 0, 0); PG8_STAGE(PG8_SA(1, 1), a1 + hstep, voffA);
            PG8_WAIT_L(8); PG8_BAR; PG8_WAIT_L(0); PG8_MMA(0, 0, At, B0); PG8_BAR; PG8_SCHED;
            PG8_LDB(B1, 0, 1); PG8_STAGE(PG8_SB(0, 0), b2, voffB);
            PG8_BAR; PG8_WAIT_L(0); PG8_MMA(0, 1, At, B1); PG8_BAR;
            PG8_LDA(At, 0, 1); PG8_STAGE(PG8_SA(0, 0), a2, voffA);
            PG8_BAR; PG8_WAIT_L(0); PG8_MMA(1, 0, At, B0); PG8_BAR; PG8_SCHED;
            PG8_STAGE(PG8_SB(0, 1), b2 + hstep, voffB);
            PG8_WAIT_V(6); PG8_BAR; PG8_MMA(1, 1, At, B1); PG8_BAR;
            PG8_LDB(B0, 1, 0); PG8_SCHED; PG8_LDA(At, 1, 0); PG8_STAGE(PG8_SA(0, 1), a2 + hstep, voffA);
            PG8_WAIT_L(8); PG8_BAR; PG8_WAIT_L(0); PG8_MMA(0, 0, At, B0); PG8_BAR; PG8_SCHED;
            PG8_LDB(B1, 1, 1); PG8_STAGE(PG8_SB(1, 0), b3, voffB);
            PG8_BAR; PG8_WAIT_L(0); PG8_MMA(0, 1, At, B1); PG8_BAR;
            PG8_LDA(At, 1, 1); PG8_STAGE(PG8_SA(1, 0), a3, voffA);
            PG8_BAR; PG8_WAIT_L(0); PG8_MMA(1, 0, At, B0); PG8_BAR; PG8_SCHED;
            PG8_STAGE(PG8_SB(1, 1), b3 + hstep, voffB);
            PG8_WAIT_V(6); PG8_BAR; PG8_MMA(1, 1, At, B1); PG8_BAR;
            }
        }
        if constexpr (ALIGN_EPI) { if (wr == 0) PG8_BAR; }
        if constexpr (!Epi::AFTER_DRAIN) { E(acc, cur, wr, wc, fr, fq); S.done(cur); }
        if (!has_next) break;
#pragma unroll
        for (int a = 0; a < 2; ++a)
#pragma unroll
            for (int b = 0; b < 2; ++b)
#pragma unroll
                for (int m = 0; m < 4; ++m)
#pragma unroll
                    for (int n = 0; n < 2; ++n) acc[a][b][m][n] = (f32x4){0.f, 0.f, 0.f, 0.f};
        cur = nxt; cA = nA; cB = nB; ++ui;
        if constexpr (ALIGN_EPI) { if (wr == 1) PG8_BAR; }
    }
    PG8_WAIT_V(0);
    if constexpr (!ALIGN_EPI) { if (wr == 0) PG8_BAR; }
    PG8_BAR;
    if constexpr (Epi::AFTER_DRAIN) { E.fused(acc, cur, wr, wc, fr, fq, lds, wid, lane); S.done(cur); }
#undef PG8_SA
#undef PG8_SB
#undef PG8_STAGE
#undef PG8_LDA
#undef PG8_LDB
#undef PG8_MMA
#undef PG8_WAIT_V
#undef PG8_WAIT_L
#undef PG8_BAR
#undef PG8_SCHED
}
}
#define GAS __attribute__((address_space(1)))
#define LAS __attribute__((address_space(3)))
typedef unsigned v4u __attribute__((ext_vector_type(4)));
typedef float f32x4 __attribute__((ext_vector_type(4)));
typedef short bf16x8 __attribute__((ext_vector_type(8)));
typedef GAS unsigned gu32;
typedef GAS unsigned long long gu64;
#define RLX_AGENT __ATOMIC_RELAXED, __HIP_MEMORY_SCOPE_AGENT
#define LDS_WAIT() asm volatile("s_waitcnt lgkmcnt(0)" ::: "memory")
#define VM_WAIT() asm volatile("s_waitcnt vmcnt(0)" ::: "memory")
__device__ __forceinline__ unsigned long long rt() { return __builtin_amdgcn_s_memrealtime(); }
__device__ __forceinline__ unsigned pk2(float lo, float hi) { return (unsigned)f2bf(lo) | ((unsigned)f2bf(hi) << 16); }

#define XB_TMO      128
#define XB_XCNT(j)  (256  + 64 * (j))
#define XB_XSUB(j)  (1280 + 64 * (j))
#define XB_XGEN(j)  (2304 + 64 * (j))
#define XB_TOP      3328
#define XB_TOPGEN   3392
#define XCD_BAR_WORDS 3456
#define XB_SPIN_CAP (1u << 22)

__device__ __forceinline__ unsigned xb_ld(unsigned* p)              { return __hip_atomic_load(p, __ATOMIC_RELAXED, __HIP_MEMORY_SCOPE_AGENT); }
__device__ __forceinline__ unsigned xb_add(unsigned* p, unsigned v) { return __hip_atomic_fetch_add(p, v, __ATOMIC_RELAXED, __HIP_MEMORY_SCOPE_AGENT); }
__device__ __forceinline__ unsigned xb_xcc_id() { return (unsigned)__builtin_amdgcn_s_getreg((3 << 11) | 20) & 0xFu; }
#define XB_SPIN(cond, bar) do { unsigned _sp = 0; while (cond) { __builtin_amdgcn_s_sleep(1); \
    if ((++_sp & 255u) == 0u) { if (xb_ld(&(bar)[XB_TMO])) break; if (_sp > XB_SPIN_CAP) { atomicAdd(&(bar)[XB_TMO], 1u); break; } } } } while (0)

struct XcdBarrier {
    unsigned* bar; unsigned x;
    volatile LAS unsigned* st;
};

__device__ __forceinline__ XcdBarrier xcd_barrier_post(unsigned* bar, volatile LAS unsigned* st) {
    XcdBarrier b; b.bar = bar; b.x = xb_xcc_id(); b.st = st;
    if (threadIdx.x == 0) (void)xb_add(&bar[XB_XCNT(b.x)], 1u);
    return b;
}
__device__ __forceinline__ void xcd_barrier_complete(unsigned* bar, unsigned x, unsigned& nloc, unsigned& nx) {
    const unsigned G = gridDim.x * gridDim.y * gridDim.z;
    unsigned sum, cnt, mine, sp = 0u;
    for (;;) {
        sum = 0u; cnt = 0u; mine = 0u;
#pragma unroll
        for (unsigned j = 0; j < 16; ++j) { const unsigned c = xb_ld(&bar[XB_XCNT(j)]); sum += c; cnt += (c > 0u) ? 1u : 0u; mine = (j == x) ? c : mine; }
        if (sum == G) break;
        __builtin_amdgcn_s_sleep(1);
        if ((++sp & 255u) == 0u) { if (xb_ld(&bar[XB_TMO])) break; if (sp > XB_SPIN_CAP) { atomicAdd(&bar[XB_TMO], 1u); break; } }
    }
    nloc = mine > 0u ? mine : 1u; nx = cnt > 0u ? cnt : 1u;
}

__device__ __forceinline__ void xcd_barrier(const XcdBarrier& b) {
    asm volatile("s_waitcnt vmcnt(0)" ::: "memory");
    __syncthreads();
    if (threadIdx.x == 0) {
        unsigned* bar = b.bar;
        __builtin_amdgcn_s_waitcnt(0);
        unsigned nloc = b.st[0], nx = b.st[1];
        if (nloc == 0u) { xcd_barrier_complete(bar, b.x, nloc, nx); b.st[0] = nloc; b.st[1] = nx; }
        const unsigned old = xb_add(&bar[XB_XSUB(b.x)], 1u);
        const unsigned gen = old / nloc;
        if (old + 1u == (gen + 1u) * nloc) {
            __builtin_amdgcn_fence(__ATOMIC_RELEASE, "agent");
            asm volatile("s_waitcnt vmcnt(0)" ::: "memory");
            const unsigned og = xb_add(&bar[XB_TOP], 1u);
            const unsigned tg = og / nx;
            if (og + 1u == (tg + 1u) * nx) xb_add(&bar[XB_TOPGEN], 1u);
            else XB_SPIN(xb_ld(&bar[XB_TOPGEN]) == tg, bar);
            __builtin_amdgcn_fence(__ATOMIC_ACQUIRE, "agent");
            xb_add(&bar[XB_XGEN(b.x)], 1u);
            asm volatile("s_waitcnt vmcnt(0)" ::: "memory");
        } else {
            XB_SPIN(xb_ld(&bar[XB_XGEN(b.x)]) == gen, bar);
            __builtin_amdgcn_fence(__ATOMIC_ACQUIRE, "agent");
            asm volatile("s_waitcnt vmcnt(0)" ::: "memory");
        }
    }
    __syncthreads();
}
namespace ep {
using pg8::f32x4; using pg8::u32x4; using pg8::Unit; using pg8::cvt_pk_bf16;
__device__ __forceinline__ float fsig(float v) { return __builtin_amdgcn_rcpf(1.f + __builtin_amdgcn_exp2f(-1.4426950408889634f * v)); }
__device__ __forceinline__ f32x4 act4(f32x4 v, int mode) {
    if (mode == 0) return v;
    f32x4 s; s[0] = fsig(v[0]); s[1] = fsig(v[1]); s[2] = fsig(v[2]); s[3] = fsig(v[3]);
    return mode == 1 ? v * s : s;
}
__device__ __forceinline__ u32x4 pack8(f32x4 a, f32x4 b) { u32x4 w; w.x = cvt_pk_bf16(a[0], a[1]); w.y = cvt_pk_bf16(a[2], a[3]); w.z = cvt_pk_bf16(b[0], b[1]); w.w = cvt_pk_bf16(b[2], b[3]); return w; }
__device__ __forceinline__ float lo16(unsigned w) { return __uint_as_float(w << 16); }
__device__ __forceinline__ float hi16(unsigned w) { return __uint_as_float(w & 0xffff0000u); }

struct EpiIn {
    static constexpr bool PERM = true, AFTER_DRAIN = false;
    unsigned char* ws; const float* q_g; const float* k_g; const float* b_if;
    __device__ __forceinline__ void operator()(const f32x4 (&acc)[2][2][4][2], const Unit& u, int wr, int wc, int fr, int fq) const {
        const int pn = u.pn; const int row0 = u.pm * 256 + wr * 64 + fr;
        if (pn < 4) {
            const bool isq = pn < 2;
            bf16_t* dst = (bf16_t*)(ws + (isq ? WS_Q : WS_K)) + (pn & 1) * 256 + 64 * wc + 8 * fq;
            const float* g = isq ? q_g : k_g;
            f32x4 gv[2][2];
#pragma unroll
            for (int bj = 0; bj < 2; ++bj)
#pragma unroll
                for (int n = 0; n < 2; ++n) gv[bj][n] = *(const f32x4*)(g + 32 * bj + 16 * n + 4 * fq);
            const float* rope = (const float*)(ws + WS_ROPE) + 4 * fq;
            const bool lat = u.pm < 128; const float sc = isq ? C2 : 1.f;
#pragma unroll
            for (int ai = 0; ai < 2; ++ai) {
                f32x4 rp4[4][4];
                if (lat) {
#pragma unroll
                    for (int m = 0; m < 4; ++m) { const int t = (row0 + ai * 128 + m * 16) & (SEQ - 1), rid = t >> 6, cid = t & 63;
                        rp4[m][0] = *(const f32x4*)(rope + rid * 16); rp4[m][1] = *(const f32x4*)(rope + 1024 + rid * 16); rp4[m][2] = *(const f32x4*)(rope + cid * 16); rp4[m][3] = *(const f32x4*)(rope + 1024 + cid * 16); }
                }
                asm volatile("" ::: "memory");
#pragma unroll
                for (int m = 0; m < 4; ++m) {
                    const int row = row0 + ai * 128 + m * 16;
                    float ss = 0.f;
#pragma unroll
                    for (int bj = 0; bj < 2; ++bj)
#pragma unroll
                        for (int n = 0; n < 2; ++n) { const f32x4 a = acc[ai][bj][m][n]; ss += (a[0] * a[0] + a[1] * a[1]) + (a[2] * a[2] + a[3] * a[3]); }
                    ss += __shfl_xor(ss, 16); ss += __shfl_xor(ss, 32);
                    const float rn = rsqrtf(ss * (1.f / 64.f) + EPS) * sc;
                    f32x4 y[2][2];
#pragma unroll
                    for (int bj = 0; bj < 2; ++bj)
#pragma unroll
                        for (int n = 0; n < 2; ++n) y[bj][n] = acc[ai][bj][m][n] * rn * gv[bj][n];
                    if (lat) {
                        const f32x4 cr = rp4[m][0], sr = rp4[m][1], cc = rp4[m][2], scn = rp4[m][3];
                        const f32x4 a0 = y[0][0] * cr - y[0][1] * sr, a1 = y[0][0] * sr + y[0][1] * cr;
                        const f32x4 b0 = y[1][0] * cc - y[1][1] * scn, b1 = y[1][0] * scn + y[1][1] * cc;
                        y[0][0] = a0; y[0][1] = a1; y[1][0] = b0; y[1][1] = b1;
                    }
                    bf16_t* rp = dst + (size_t)row * 512;
                    *(u32x4*)(rp) = pack8(y[0][0], y[0][1]);
                    *(u32x4*)(rp + 32) = pack8(y[1][0], y[1][1]);
                }
                asm volatile("" ::: "memory");
            }
        } else if (pn < 24) {
            size_t off; int ld, cb, mode;
            if (pn < 16) { ld = 512; cb = (pn & 1) * 256; const int s = pn >> 1;
                off = s == 2 ? WS_V : s == 3 ? WS_ZA : s == 4 ? WS_XM : s == 5 ? WS_VM : s == 6 ? WS_ZB : WS_OB;
                mode = (s == 3 || s == 6) ? 1 : (s == 7 ? 2 : 0); }
            else { ld = 1024; cb = ((pn - 16) & 3) * 256; off = pn < 20 ? WS_GA : WS_GB; mode = 2; }
            bf16_t* dst = (bf16_t*)(ws + off) + cb + 32 * wc + 8 * fq;
#pragma unroll
            for (int ai = 0; ai < 2; ++ai)
#pragma unroll
                for (int m = 0; m < 4; ++m) { bf16_t* rp = dst + (size_t)(row0 + ai * 128 + m * 16) * ld;
#pragma unroll
                    for (int bj = 0; bj < 2; ++bj) *(u32x4*)(rp + bj * 128) = pack8(act4(acc[ai][bj][m][0], mode), act4(acc[ai][bj][m][1], mode)); }
        } else {
            if (wc == 0 && fq < 2) {
                float* G = (float*)(ws + WS_GATES) + 8 * fq;
                const f32x4 bi = *(const f32x4*)(b_if + 8 * fq), bf = *(const f32x4*)(b_if + 8 * fq + 4);
#pragma unroll
                for (int ai = 0; ai < 2; ++ai)
#pragma unroll
                    for (int m = 0; m < 4; ++m) { float* rp = G + (size_t)(row0 + ai * 128 + m * 16) * 16;
                        const f32x4 vi = acc[ai][0][m][0] + bi; f32x4 vf = acc[ai][0][m][1] + bf;
#pragma unroll
                        for (int i = 0; i < 4; ++i) { const float x = vf[i]; vf[i] = fminf(x, 0.f) - 0.6931471805599453f * __builtin_amdgcn_logf(1.f + __builtin_amdgcn_exp2f(-1.4426950408889634f * fabsf(x))); }
                        *(f32x4*)rp = vi; *(f32x4*)(rp + 4) = vf; }
            }
        }
    }
};
struct EpiMerge {
    static constexpr bool PERM = true, AFTER_DRAIN = false;
    bf16_t* GA; bf16_t* GB;
    __device__ __forceinline__ void operator()(const f32x4 (&acc)[2][2][4][2], const Unit& u, int wr, int wc, int fr, int fq) const {
        const int row0 = u.pm * 256 + wr * 64 + fr; const int col0 = u.pn * 256 + 32 * wc + 8 * fq; const bool second = (u.sel & 1) != 0; const bool dry = (u.sel & 2) != 0;
        bf16_t* G = second ? GB : GA;
#pragma unroll
        for (int ai = 0; ai < 2; ++ai) {
            u32x4 gwv[4][2], awv[4][2];
#pragma unroll
            for (int m = 0; m < 4; ++m) { const size_t ro = (size_t)(row0 + ai * 128 + m * 16) * 1024 + col0;
#pragma unroll
                for (int bj = 0; bj < 2; ++bj) { gwv[m][bj] = *(const u32x4*)(G + ro + bj * 128); if (second) awv[m][bj] = *(const u32x4*)(GA + ro + bj * 128); } }
            asm volatile("" ::: "memory");
#pragma unroll
            for (int m = 0; m < 4; ++m) { const size_t ro = (size_t)(row0 + ai * 128 + m * 16) * 1024 + col0;
#pragma unroll
                for (int bj = 0; bj < 2; ++bj) { const size_t o = ro + bj * 128; const u32x4 gw = gwv[m][bj];
                    f32x4 g0 = {lo16(gw.x), hi16(gw.x), lo16(gw.y), hi16(gw.y)}, g1 = {lo16(gw.z), hi16(gw.z), lo16(gw.w), hi16(gw.w)};
                    f32x4 v0 = g0 * acc[ai][bj][m][0], v1 = g1 * acc[ai][bj][m][1];
                    if (second) { const u32x4 aw = awv[m][bj];
                        v0 += (f32x4){lo16(aw.x), hi16(aw.x), lo16(aw.y), hi16(aw.y)}; v1 += (f32x4){lo16(aw.z), hi16(aw.z), lo16(aw.w), hi16(aw.w)}; }
                    if (!dry) *(u32x4*)(G + o) = pack8(v0, v1); } }
            asm volatile("" ::: "memory");
        }
    }
};
struct EpiOut {
    static constexpr bool PERM = false, AFTER_DRAIN = false;
    const float* x; const float* mod; float* out;
    __device__ __forceinline__ void operator()(const f32x4 (&acc)[2][2][4][2], const Unit& u, int wr, int wc, int fr, int fq) const {
        const int row0 = u.pm * 256 + wr * 64 + fr; const int col0 = u.pn * 256 + 32 * wc + 4 * fq;
        const float* gt = mod + (size_t)(u.pm >> 3) * 3072 + 2048 + col0;
        f32x4 gv[2][2];
#pragma unroll
        for (int bj = 0; bj < 2; ++bj)
#pragma unroll
            for (int n = 0; n < 2; ++n) gv[bj][n] = *(const f32x4*)(gt + bj * 128 + n * 16);
#pragma unroll
        for (int ai = 0; ai < 2; ++ai) {
            f32x4 xv[4][2][2];
#pragma unroll
            for (int m = 0; m < 4; ++m) { const size_t ro = (size_t)(row0 + ai * 128 + m * 16) * 1024 + col0;
#pragma unroll
                for (int bj = 0; bj < 2; ++bj)
#pragma unroll
                    for (int n = 0; n < 2; ++n) xv[m][bj][n] = *(const f32x4*)(x + ro + bj * 128 + n * 16); }
            asm volatile("" ::: "memory");
#pragma unroll
            for (int m = 0; m < 4; ++m) { const size_t ro = (size_t)(row0 + ai * 128 + m * 16) * 1024 + col0;
#pragma unroll
                for (int bj = 0; bj < 2; ++bj)
#pragma unroll
                    for (int n = 0; n < 2; ++n) *(f32x4*)(out + ro + bj * 128 + n * 16) = xv[m][bj][n] + gv[bj][n] * acc[ai][bj][m][n]; }
            asm volatile("" ::: "memory");
        }
    }
};
struct SchedIn {
    pg8::StaticOrder so; int G, c;
    __device__ void init(int G_, int c_) { so.init(R, 24 * 256, G_, c_); G = G_; c = c_; }
    __device__ __forceinline__ bool next(int i, Unit& u) const {
#if defined(PROBE_DUP) && ((PROBE_DUP >> 2) & 1)
        { const int nr = (3328 + G - 1) / G; if (i >= nr) { if (i >= 2 * nr) return false; i -= nr; } }
#endif
        Unit t; const bool reg = so.next(i, t);
        const int Lp = (int)((long)i * G + c - 3072);
        const bool ok = reg || Lp < 256;
        const int idx = Lp >> 4;
        const int pm2 = Lp < 128 ? 128 + (Lp & 15) : Lp - 128;
        const int pn2 = Lp < 128 ? (idx < 4 ? 2 + idx : 4 + idx) : 24;
        u.pm = reg ? t.pm : pm2; u.pn = reg ? t.pn : pn2; u.sel = 0;
        return ok;
    }
    __device__ __forceinline__ void a_ready(const Unit&) const {}
    __device__ __forceinline__ void done(const Unit&) const {}
};
struct SchedMerge {
    pg8::StaticOrder so;
    __device__ void init(int G_, int c_) { so.init(R, 1024, G_, c_); }
    __device__ __forceinline__ bool next(int i, Unit& u) const { int dry = 0;
#if defined(PROBE_DUP) && ((PROBE_DUP >> 6) & 1)
        { const int nr = 2 * ((512 + so.G - 1) / so.G); if (i >= 2 * nr) return false; if (i < nr) dry = 2; else i -= nr; }
#endif
        Unit t; const bool ok = so.next(i >> 1, t); u.pm = t.pm; u.pn = t.pn; u.sel = (i & 1) | dry; return ok; }
    __device__ __forceinline__ void a_ready(const Unit&) const {}
    __device__ __forceinline__ void done(const Unit&) const {}
};
struct SchedOut {
    pg8::StaticOrder so; int G;
    __device__ void init(int G_, int c_) { so.init(R, 1024, G_, c_); G = G_; }
    __device__ __forceinline__ bool next(int i, Unit& u) const {
#if defined(PROBE_DUP) && ((PROBE_DUP >> 7) & 1)
        { const int nr = (512 + G - 1) / G; if (i >= nr) { if (i >= 2 * nr) return false; i -= nr; } }
#endif
        return so.next(i, u); }
    __device__ __forceinline__ void a_ready(const Unit&) const {}
    __device__ __forceinline__ void done(const Unit&) const {}
};
}

constexpr int NWAVES = 8;
constexpr int RING_OFF = 0, RING_BYTES = 131072;
constexpr int LDSCTL_OFF = 150 * 1024, MISC_OFF = LDSCTL_OFF + 320;
constexpr int LDS_BYTES = 152 * 1024;
typedef unsigned u32x4_t __attribute__((ext_vector_type(4)));
constexpr int CW_TMO = 0, CW_CODE = 1, CW_BAR = 4096;
constexpr size_t CTL_ZERO_BYTES = 256 * 1024;

struct Frame {
    LAS unsigned char* lds; volatile LAS unsigned* MISC; gu32* ctl;
    int tid, lane, wave, vcu, G;
};
__device__ __forceinline__ float wave_sum(float v) {
#pragma unroll
    for (int o = 1; o < 64; o <<= 1) v += __shfl_xor(v, o);
    return v;
}
__device__ __forceinline__ int dmap32(int j) { return 4 * (j >> 3) + (j & 3) + 16 * ((j >> 2) & 1); }
struct TrItem { const float* W; int ldw, src, mode, valid; bf16_t* WT; int Kd, dstrow0, k0; float scale; };
__device__ __forceinline__ void tr_load(const TrItem& t, float (&wv)[32], int lane) {
    const int cl = lane & 31;
#pragma unroll
    for (int i = 0; i < 32; ++i) { const int kk = 2 * i + (lane >> 5); wv[i] = cl < t.valid ? __builtin_nontemporal_load(t.W + (size_t)(t.k0 + kk) * t.ldw + t.src + cl) : 0.f; }
}
__device__ __forceinline__ void tr_store(const TrItem& t, const float (&wv)[32], LAS float* scr, int lane) {
    const int cl = lane & 31;
#pragma unroll
    for (int i = 0; i < 32; ++i) { const int kk = 2 * i + (lane >> 5); scr[kk * 33 + cl] = wv[i] * t.scale; }
    LDS_WAIT(); asm volatile("" ::: "memory");
    const int c = lane & 7;
#pragma unroll
    for (int j = 0; j < 4; ++j) { const int n = (lane >> 3) + 8 * j; const int sn = t.mode ? dmap32(n) : n; const LAS float* s = scr + (8 * c) * 33 + sn;
        v4u o; o.x = pk2(s[0 * 33], s[1 * 33]); o.y = pk2(s[2 * 33], s[3 * 33]); o.z = pk2(s[4 * 33], s[5 * 33]); o.w = pk2(s[6 * 33], s[7 * 33]);
        *(GAS v4u*)(t.WT + (size_t)(t.dstrow0 + n) * t.Kd + t.k0 + 8 * c) = o; }
    LDS_WAIT(); asm volatile("" ::: "memory");
}
__device__ __forceinline__ TrItem tr_desc(const P& p, int it) {
    constexpr int I_IN = 16 * 200, I_OA = 8 * 32, I_O = 16 * 32;
    TrItem t; t.mode = 0; t.valid = 32; t.scale = 1.f;
    int r = it;
    if (r < I_IN) { const int kb = r / 200, nb = r % 200; int src;
        if (nb < 32) { const int tile = nb >> 3, bj = (nb & 7) >> 2, wc = nb & 3; src = 256 * tile + 64 * wc + 32 * bj; t.mode = 1; }
        else if (nb < 128) src = 32 * nb;
        else if (nb < 192) src = 32 * nb + 16;
        else { src = 4096; t.valid = nb == 192 ? 16 : 0; }
        t.W = p.w_in; t.ldw = INW; t.src = src; t.WT = (bf16_t*)(p.ws + WS_WTIN); t.Kd = 1024; t.dstrow0 = 32 * nb; t.k0 = 64 * kb; return t; }
    r -= I_IN;
    if (r < 2 * I_OA) { const int m = r >= I_OA; r -= m * I_OA; t.W = m ? p.w_out_b : p.w_out_a; t.ldw = 1024; t.src = 32 * (r % 32); t.WT = (bf16_t*)(p.ws + (m ? WS_WTOB : WS_WTOA)); t.Kd = 512; t.dstrow0 = 32 * (r % 32); t.k0 = 64 * (r / 32); return t; }
    r -= 2 * I_OA;
    if (r < I_O) { t.W = p.w_o; t.ldw = 1024; t.src = 32 * (r % 32); t.WT = (bf16_t*)(p.ws + WS_WTO); t.Kd = 1024; t.dstrow0 = 32 * (r % 32); t.k0 = 64 * (r / 32); return t; }
    r -= I_O;
    { const int mat = r >> 5, hh = (r >> 3) & 3, kb = (r >> 2) & 1, nb = r & 3;
      t.W = (mat ? p.wk : p.wq) + hh * 16384; t.ldw = 128; t.src = 32 * nb; t.WT = (bf16_t*)(p.ws + WS_MWQ) + mat * 65536 + hh * 16384; t.Kd = 128; t.dstrow0 = 32 * nb; t.k0 = 64 * kb; t.scale = mat ? 0.08838834764831845f : 1.f; }
    return t;
}
__device__ __forceinline__ void p_transposes(Frame& F, const P& p) {
    LAS float* scr = (LAS float*)(F.lds + RING_OFF + F.wave * 16384);
    const int gw = F.vcu * NWAVES + F.wave, NGW = F.G * NWAVES;
    constexpr int NITEMS = 16 * 200 + 2 * 8 * 32 + 16 * 32 + 64;
    for (int it = gw; it < NITEMS; it += 2 * NGW) {
        const int itb = it + NGW; const bool hasb = itb < NITEMS;
        const TrItem ta = tr_desc(p, it), tb = tr_desc(p, hasb ? itb : it);
        float wa[32], wb[32];
        tr_load(ta, wa, F.lane); if (hasb) tr_load(tb, wb, F.lane);
        tr_store(ta, wa, scr, F.lane); if (hasb) tr_store(tb, wb, scr, F.lane);
    }
}
__device__ __forceinline__ void p0_prologue(Frame& F, const P& p) {
    float* rope = (float*)(p.ws + WS_ROPE);
    if (F.vcu == F.G - 1) {
        for (int i = F.tid; i < 1024; i += NWAVES * 64) { const int pos = i >> 4, f = i & 15; const float inv = __builtin_amdgcn_exp2f(-(float)f * (13.287712379549449f / 16.0f));
            const float rev = (float)pos * inv * 0.15915494309189535f; rope[i] = __builtin_amdgcn_cosf(rev); rope[1024 + i] = __builtin_amdgcn_sinf(rev); }
        if (F.wave == 0) { const float s1 = wave_sum(p.lq1[F.lane] * p.lk1[F.lane]), s2 = wave_sum(p.lq2[F.lane] * p.lk2[F.lane]);
            float gq = fabsf(p.q_g[F.lane]), gk = fabsf(p.k_g[F.lane]);
#pragma unroll
            for (int o = 1; o < 64; o <<= 1) { gq = fmaxf(gq, __shfl_xor(gq, o)); gk = fmaxf(gk, __shfl_xor(gk, o)); }
            if (F.lane == 0) { rope[2048] = expf(s1) - expf(s2) + LAM_INIT; rope[2049] = fminf(C2 * 64.f * gq * gk, 60.f); } }
    }
    for (int grp = F.vcu; grp < 96; grp += F.G) {
        LAS float* sc = (LAS float*)(F.lds + RING_OFF);
        LAS float* red = sc + 17 * 1024;
        __syncthreads();
        for (int i = F.tid; i < 17 * 1024; i += NWAVES * 64) { const int b = i >> 10, k = i & 1023; const float v = b < 16 ? p.c[b * 1024 + k] : p.c_ctx[k]; sc[i] = v * ep::fsig(v); }
        __syncthreads();
        const int cl = F.lane & 31, col = grp * 32 + cl, k0 = F.wave * 128 + (F.lane >> 5) * 64;
        float acc[17];
#pragma unroll
        for (int b = 0; b < 17; ++b) acc[b] = 0.f;
#pragma unroll 32
        for (int k = k0; k < k0 + 64; ++k) { const float w = __builtin_nontemporal_load(p.w_mod + (size_t)k * 3072 + col);
#pragma unroll
            for (int b = 0; b < 17; ++b) acc[b] += sc[b * 1024 + k] * w; }
#pragma unroll
        for (int b = 0; b < 17; ++b) { acc[b] += __shfl_xor(acc[b], 32); if (F.lane < 32) red[(F.wave * 17 + b) * 32 + cl] = acc[b]; }
        __syncthreads();
        float* mod = (float*)(p.ws + WS_MOD);
        for (int i = F.tid; i < 17 * 32; i += NWAVES * 64) { const int b = i >> 5, cc = i & 31; float s = p.b_mod[grp * 32 + cc];
#pragma unroll
            for (int w = 0; w < 8; ++w) s += red[(w * 17 + b) * 32 + cc];
            mod[b * 3072 + grp * 32 + cc] = s; }
    }
    __syncthreads();
}
__device__ __forceinline__ void p1_hrows(Frame& F, const P& p) {
    const int gw = F.vcu * NWAVES + F.wave, NGW = F.G * NWAVES;
    LAS float* wg = (LAS float*)(F.lds + RING_OFF);
    __syncthreads();
    for (int kk = F.tid; kk < 1024; kk += NWAVES * 64) { const f32x4* src = (const f32x4*)(p.w_in + (size_t)kk * INW + 4096);
#pragma unroll
        for (int q = 0; q < 4; ++q) { const f32x4 v = src[q]; wg[(4 * q) * 1024 + kk] = v.x; wg[(4 * q + 1) * 1024 + kk] = v.y; wg[(4 * q + 2) * 1024 + kk] = v.z; wg[(4 * q + 3) * 1024 + kk] = v.w; } }
    __syncthreads();
    const float* mod = (const float*)(p.ws + WS_MOD); bf16_t* H = (bf16_t*)(p.ws + WS_H);
    f32x4 nw[4];
#pragma unroll
    for (int j = 0; j < 4; ++j) nw[j] = ((const f32x4*)p.norm_w)[F.lane + 64 * j];
    for (int row = gw; row < RC; row += NGW) {
        const float* xr; int b;
        if (row < R) { xr = p.x + (size_t)row * 1024; b = row >> 11; } else { xr = p.ctx + (size_t)(row - R) * 1024; b = 16; }
        const f32x4* xv = (const f32x4*)xr + F.lane; const f32x4* sh = (const f32x4*)(mod + b * 3072) + F.lane; const f32x4* sc = (const f32x4*)(mod + b * 3072 + 1024) + F.lane;
        f32x4 v[4]; float s = 0.f;
#pragma unroll
        for (int j = 0; j < 4; ++j) { v[j] = __builtin_nontemporal_load(xv + 64 * j); s += (v[j].x * v[j].x + v[j].y * v[j].y) + (v[j].z * v[j].z + v[j].w * v[j].w); }
        const float rn = rsqrtf(wave_sum(s) * (1.f / 1024.f) + EPS);
        unsigned long long* o8 = (unsigned long long*)(H + (size_t)row * 1024) + F.lane;
        f32x4 y[4];
#pragma unroll
        for (int j = 0; j < 4; ++j) { y[j] = v[j] * rn * nw[j] * (sc[64 * j] + 1.f) + sh[64 * j];
            o8[64 * j] = (unsigned long long)pg8::cvt_pk_bf16(y[j].x, y[j].y) | ((unsigned long long)pg8::cvt_pk_bf16(y[j].z, y[j].w) << 32); }
        if (row >= R) {
            float pg[16];
#pragma unroll
            for (int g = 0; g < 16; ++g) { float s = 0.f;
#pragma unroll
                for (int j = 0; j < 4; ++j) { const f32x4 w = *(const LAS f32x4*)(wg + g * 1024 + 4 * F.lane + 256 * j); s += (y[j].x * w.x + y[j].y * w.y) + (y[j].z * w.z + y[j].w * w.w); }
                pg[g] = s; }
            { const bool u5 = (F.lane & 32) != 0;
#pragma unroll
              for (int i = 0; i < 8; ++i) { const float mine_ = u5 ? pg[8 + i] : pg[i], send = u5 ? pg[i] : pg[8 + i]; pg[i] = mine_ + __shfl_xor(send, 32); } }
            { const bool u4 = (F.lane & 16) != 0;
#pragma unroll
              for (int i = 0; i < 4; ++i) { const float mine_ = u4 ? pg[4 + i] : pg[i], send = u4 ? pg[i] : pg[4 + i]; pg[i] = mine_ + __shfl_xor(send, 16); } }
            { const bool u3 = (F.lane & 8) != 0;
#pragma unroll
              for (int i = 0; i < 2; ++i) { const float mine_ = u3 ? pg[2 + i] : pg[i], send = u3 ? pg[i] : pg[2 + i]; pg[i] = mine_ + __shfl_xor(send, 8); } }
            { const bool u2 = (F.lane & 4) != 0; const float mine_ = u2 ? pg[1] : pg[0], send = u2 ? pg[0] : pg[1]; pg[0] = mine_ + __shfl_xor(send, 4); }
            float s = pg[0]; s += __shfl_xor(s, 1); s += __shfl_xor(s, 2);
            if ((F.lane & 3) == 0) { const int g = F.lane >> 2; s += p.b_if[g]; if ((g >> 2) & 1) s = fminf(s, 0.f) - log1pf(expf(-fabsf(s)));
                ((float*)(p.ws + WS_GATES))[(size_t)row * 16 + g] = s; }
        }
    }
    __syncthreads();
}


namespace att {
using bf16x8 = __attribute__((ext_vector_type(8))) short;
using s16x4 = __attribute__((ext_vector_type(4))) short;
using f32x16 = __attribute__((ext_vector_type(16))) float;
using u32x4 = __attribute__((ext_vector_type(4))) unsigned;
typedef short v4i16_t __attribute__((ext_vector_type(4)));
typedef float f32x2_t __attribute__((ext_vector_type(2))); typedef __bf16 bf16x2_t __attribute__((ext_vector_type(2)));
constexpr int SLOT = 16384, LDS_K = 0, LDS_V = 3 * SLOT, LDS_WS = 6 * SLOT, NT = NKEY / 64, STLD = 132;
__device__ __forceinline__ int crow(int r, int hi) { return (r & 3) + 8 * (r >> 2) + 4 * hi; }
__device__ __forceinline__ void glds16(const void* gsrc, unsigned lds_dst) { unsigned keep;
    asm volatile("s_mov_b32 %0, m0\n\ts_mov_b32 m0, %2\n\ts_nop 0\n\tglobal_load_lds_dwordx4 %1, off\n\ts_mov_b32 m0, %0" : "=&s"(keep) : "v"(gsrc), "s"(lds_dst) : "memory"); }
__device__ __forceinline__ unsigned cvtpk_s(float lo, float hi) { f32x2_t v = {lo, hi}; bf16x2_t b = __builtin_convertvector(v, bf16x2_t); return __builtin_bit_cast(unsigned, b); }
typedef LAS const char* lds_cptr;
__device__ __forceinline__ s16x4 vtr(lds_cptr p) { return __builtin_bit_cast(s16x4, __builtin_amdgcn_ds_read_tr16_b64_v4i16((LAS v4i16_t*)p)); }
#define ATT_WAIT_BAR(N) asm volatile("s_waitcnt vmcnt(" #N ") lgkmcnt(0)\n\ts_barrier" ::: "memory")
#define ATT_MFMA(a, b, c) __builtin_amdgcn_mfma_f32_32x32x16_bf16(a, b, c, 0, 0, 0)

__device__ __forceinline__ void attn_unit(int b, int h, int qb, const P& p, LAS unsigned char* shm, float lam, float Mref, bool dry) {
    const int tid = threadIdx.x, lane = tid & 63, r32 = lane & 31, hi = lane >> 5; const int wid = __builtin_amdgcn_readfirstlane(tid >> 6);
    const int map = wid >> 2, qsub = wid & 3;
    bf16_t* Qb = (bf16_t*)(p.ws + WS_Q); const bf16_t* Kb = (const bf16_t*)(p.ws + WS_K); const bf16_t* Vb = (const bf16_t*)(p.ws + WS_V);
    const size_t qrow0 = (size_t)b * SEQ + qb * 128;
    bf16x8 qr[4];
    { const bf16_t* Qw = Qb + (qrow0 + qsub * 32 + r32) * 512 + h * 128 + map * 64 + hi * 8;
#pragma unroll
      for (int d0 = 0; d0 < 4; ++d0) qr[d0] = *(const bf16x8*)(Qw + d0 * 16); }
    const unsigned lds0 = (unsigned)(uintptr_t)shm;
    const bf16_t* ksrc = Kb + (size_t)lane * 512 + h * 128 + wid * 8;
    const bf16_t* vsrc = Vb + (size_t)(16 * (wid & 3) + (lane >> 2)) * 512 + h * 128 + (wid >> 2) * 32 + (lane & 3) * 8;
    const unsigned kdst = lds0 + LDS_K + wid * 1024, vdst = lds0 + LDS_V + (wid >> 2) * 4096 + (wid & 3) * 1024;
#define ATT_TROW(t) ((t) < 4 ? (size_t)R + (size_t)b * CTX + (size_t)(t) * 64 : (size_t)b * SEQ + (size_t)((t) - 4) * 64)
#define ATT_DMA(t, slot) do { const size_t ro_ = ATT_TROW(t) * 512; \
        glds16(ksrc + ro_, (unsigned)__builtin_amdgcn_readfirstlane(kdst + (slot))); glds16(ksrc + ro_ + 64, (unsigned)__builtin_amdgcn_readfirstlane(kdst + (slot) + 8192)); \
        glds16(vsrc + ro_, (unsigned)__builtin_amdgcn_readfirstlane(vdst + (slot))); glds16(vsrc + ro_ + 64, (unsigned)__builtin_amdgcn_readfirstlane(vdst + (slot) + 8192)); } while (0)
    ATT_DMA(0, 0); ATT_DMA(1, SLOT);
    const lds_cptr shm3 = (lds_cptr)shm;
    const lds_cptr kp0 = shm3 + LDS_K + map * 8192 + hi * 1024 + r32 * 16;
    const lds_cptr vp0 = shm3 + LDS_V + ((lane >> 4) & 1) * 32 + (lane & 3) * 8 + (4 * hi + ((lane & 15) >> 2)) * 64;
    f32x16 o[4]; o[0] = f32x16{}; o[1] = f32x16{}; o[2] = f32x16{}; o[3] = f32x16{};
    f32x16 negm;
#pragma unroll
    for (int r = 0; r < 16; ++r) negm[r] = -Mref;
    float l_reg = 0.f;
    ATT_WAIT_BAR(4);
    int sl_cur = 0, sl_n2 = 2 * SLOT;
    for (int t = 0; t < NT; ++t) {
        if (t + 2 < NT) ATT_DMA(t + 2, sl_n2);
        const lds_cptr kp = kp0 + sl_cur, vp = vp0 + sl_cur;
        f32x16 p0, p1;
#pragma unroll
        for (int d0 = 0; d0 < 4; ++d0) {
            const bf16x8 b0 = *(const LAS bf16x8*)(kp + d0 * 2048), b1 = *(const LAS bf16x8*)(kp + d0 * 2048 + 512);
            if (d0 == 0) { p0 = ATT_MFMA(b0, qr[0], negm); p1 = ATT_MFMA(b1, qr[0], negm); }
            else { p0 = ATT_MFMA(b0, qr[d0], p0); p1 = ATT_MFMA(b1, qr[d0], p1); }
        }
        float sacc = 0.f;
#pragma unroll
        for (int r = 0; r < 16; ++r) { p0[r] = __builtin_amdgcn_exp2f(p0[r]); p1[r] = __builtin_amdgcn_exp2f(p1[r]); sacc += p0[r] + p1[r]; }
        l_reg += sacc;
        u32x4 pw[4];
#pragma unroll
        for (int k = 0; k < 4; ++k) { pw[0][k] = cvtpk_s(p0[2 * k], p0[2 * k + 1]); pw[1][k] = cvtpk_s(p0[8 + 2 * k], p0[9 + 2 * k]); pw[2][k] = cvtpk_s(p1[2 * k], p1[2 * k + 1]); pw[3][k] = cvtpk_s(p1[8 + 2 * k], p1[9 + 2 * k]); }
#pragma unroll
        for (int d0 = 0; d0 < 4; ++d0)
#pragma unroll
            for (int ks = 0; ks < 4; ++ks) {
                const s16x4 lo = vtr(vp + d0 * 4096 + ks * 1024), hh = vtr(vp + d0 * 4096 + ks * 1024 + 512);
                const bf16x8 vf = (bf16x8){lo[0], lo[1], lo[2], lo[3], hh[0], hh[1], hh[2], hh[3]};
                o[d0] = ATT_MFMA(__builtin_bit_cast(bf16x8, pw[ks]), vf, o[d0]);
            }
        if (t + 2 < NT) { ATT_WAIT_BAR(4); } else { ATT_WAIT_BAR(0); }
        sl_n2 = sl_cur; sl_cur = (sl_cur == 2 * SLOT) ? 0 : sl_cur + SLOT;
    }
    const size_t go = (qrow0 + (tid >> 2)) * 512 + h * 128 + (tid & 3) * 32;
    u32x4 zwv[4];
    { const bf16_t* za = (const bf16_t*)(p.ws + WS_ZA) + go;
#pragma unroll
      for (int i = 0; i < 4; ++i) zwv[i] = *(const u32x4*)(za + 8 * i); }
    LAS float* wsf = (LAS float*)(shm + LDS_WS) + wid * 64;
    { auto rr = __builtin_amdgcn_permlane32_swap(__float_as_uint(l_reg), __float_as_uint(l_reg), false, false); l_reg = __uint_as_float(rr[0]) + __uint_as_float(rr[1]); }
    if (hi == 0) wsf[r32] = l_reg;
    asm volatile("s_waitcnt lgkmcnt(0)" ::: "memory");
    float scl[16];
#pragma unroll
    for (int r = 0; r < 16; ++r) scl[r] = __builtin_amdgcn_rcpf(wsf[crow(r, hi)]) * (map ? lam : 1.f);
    LAS float* stage = (LAS float*)shm;
    const int qloc = qsub * 32;
    if (map == 1) {
#pragma unroll
        for (int d0 = 0; d0 < 4; ++d0)
#pragma unroll
            for (int r = 0; r < 16; ++r) stage[(qloc + crow(r, hi)) * STLD + 32 * d0 + r32] = o[d0][r] * scl[r];
    }
    asm volatile("s_waitcnt lgkmcnt(0)\n\ts_barrier" ::: "memory");
    if (map == 0) {
#pragma unroll
        for (int d0 = 0; d0 < 4; ++d0)
#pragma unroll
            for (int r = 0; r < 16; ++r) { LAS float* sp = stage + (qloc + crow(r, hi)) * STLD + 32 * d0 + r32; *sp = o[d0][r] * scl[r] - *sp; }
    }
    asm volatile("s_waitcnt lgkmcnt(0)\n\ts_barrier" ::: "memory");
    {
        const int row = tid >> 2, qu = tid & 3;
        const LAS float* sp = stage + row * STLD + qu * 32;
        f32x4 v[8]; float ss = 0.f;
#pragma unroll
        for (int i = 0; i < 8; ++i) { v[i] = *(const LAS f32x4*)(sp + 4 * i); ss += (v[i].x * v[i].x + v[i].y * v[i].y) + (v[i].z * v[i].z + v[i].w * v[i].w); }
        ss += __shfl_xor(ss, 1); ss += __shfl_xor(ss, 2);
        const float rn = rsqrtf(ss * (1.f / 128.f) + EPS) * (1.f - LAM_INIT);
        const float* hg = p.head_g + qu * 32;
#pragma unroll
        for (int i = 0; i < 4; ++i) { const u32x4 zw = zwv[i]; const f32x4 g0 = *(const f32x4*)(hg + 8 * i), g1 = *(const f32x4*)(hg + 8 * i + 4);
            const f32x4 z0 = {ep::lo16(zw.x), ep::hi16(zw.x), ep::lo16(zw.y), ep::hi16(zw.y)}, z1 = {ep::lo16(zw.z), ep::hi16(zw.z), ep::lo16(zw.w), ep::hi16(zw.w)};
            if (!dry) *(u32x4*)(Qb + go + 8 * i) = ep::pack8(v[2 * i] * rn * g0 * z0, v[2 * i + 1] * rn * g1 * z1); }
    }
    asm volatile("s_waitcnt lgkmcnt(0)\n\ts_barrier" ::: "memory");
#undef ATT_DMA
#undef ATT_TROW
}
__device__ __forceinline__ void attn_phase(Frame& F, const P& p, bool dry) {
    const float* sc = (const float*)(p.ws + WS_ROPE) + 2048;
    const float lam = sc[0], Mref = sc[1];
    const int per = (1024 + F.G - 1) / F.G;
    if (F.G == 256) {
        for (int i = 0; i < 4; ++i) { const int bh = (F.vcu >> 4) + 16 * i; attn_unit(bh >> 2, bh & 3, F.vcu & 15, p, F.lds + RING_OFF, lam, Mref, dry); }
    } else
    for (int i = 0; i < per; ++i) { const int u = F.vcu * per + i; if (u < 1024) attn_unit(u >> 6, (u >> 4) & 3, u & 15, p, F.lds + RING_OFF, lam, Mref, dry); }
}
}

namespace ml {
__device__ __forceinline__ void f8(const u32x4_t w, float* o) { o[0] = ep::lo16(w.x); o[1] = ep::hi16(w.x); o[2] = ep::lo16(w.y); o[3] = ep::hi16(w.y); o[4] = ep::lo16(w.z); o[5] = ep::hi16(w.z); o[6] = ep::lo16(w.w); o[7] = ep::hi16(w.w); }
__device__ __forceinline__ void finish_phase(Frame& F, const P& p) {
    const int gw = F.vcu * NWAVES + F.wave, NGW = F.G * NWAVES; const int c0 = F.lane * 8;
    float cw0[8], cw1[8], cw2[8], cbv[8], hg[8], sk[8];
#pragma unroll
    for (int i = 0; i < 8; ++i) { cw0[i] = p.conv_w[c0 + i]; cw1[i] = p.conv_w[512 + c0 + i]; cw2[i] = p.conv_w[1024 + c0 + i]; cbv[i] = p.conv_b[c0 + i]; hg[i] = p.ml_head_g[c0 + i]; sk[i] = p.ml_skip[c0 + i]; }
    const bf16_t* HF = (const bf16_t*)(p.ws + WS_HF); const bf16_t* HB = (const bf16_t*)(p.ws + WS_HB); const bf16_t* XM = (const bf16_t*)(p.ws + WS_XM);
    const bf16_t* OB = (const bf16_t*)(p.ws + WS_OB); const bf16_t* ZB = (const bf16_t*)(p.ws + WS_ZB); bf16_t* YB = (bf16_t*)(p.ws + WS_YB);
    for (int row = gw; row < R; row += NGW) {
        const size_t o = (size_t)row * 512 + c0; const int t = row & (SEQ - 1);
        float hf[8], hb[8], x0[8], x1[8], x2[8], ob[8], zb[8];
        f8(*(const u32x4_t*)(HF + o), hf); f8(*(const u32x4_t*)(HB + o), hb); f8(*(const u32x4_t*)(XM + o), x1);
        f8(*(const u32x4_t*)(OB + o), ob); f8(*(const u32x4_t*)(ZB + o), zb);
        if (t > 0) f8(*(const u32x4_t*)(XM + o - 512), x0); else {
#pragma unroll
            for (int i = 0; i < 8; ++i) x0[i] = 0.f; }
        if (t < SEQ - 1) f8(*(const u32x4_t*)(XM + o + 512), x2); else {
#pragma unroll
            for (int i = 0; i < 8; ++i) x2[i] = 0.f; }
        float ss = 0.f;
#pragma unroll
        for (int i = 0; i < 8; ++i) { hf[i] += hb[i]; ss += hf[i] * hf[i]; }
        ss += __shfl_xor(ss, 1); ss += __shfl_xor(ss, 2); ss += __shfl_xor(ss, 4); ss += __shfl_xor(ss, 8);
        const float rn = rsqrtf(ss * (1.f / 128.f) + EPS);
        float y[8];
#pragma unroll
        for (int i = 0; i < 8; ++i) { const float a = cbv[i] + cw0[i] * x0[i] + cw1[i] * x1[i] + cw2[i] * x2[i]; const float xcv = a * ep::fsig(a);
            y[i] = (ob[i] * (hf[i] * rn * hg[i]) + sk[i] * xcv) * zb[i]; }
        u32x4_t w; w.x = pg8::cvt_pk_bf16(y[0], y[1]); w.y = pg8::cvt_pk_bf16(y[2], y[3]); w.z = pg8::cvt_pk_bf16(y[4], y[5]); w.w = pg8::cvt_pk_bf16(y[6], y[7]);
        *(u32x4_t*)(YB + o) = w;
    }
}
}

namespace mlf {
using bf16x8 = __attribute__((ext_vector_type(8))) short;
using s16x4 = __attribute__((ext_vector_type(4))) short;
using f32x16 = __attribute__((ext_vector_type(16))) float;
typedef short v4i16_t __attribute__((ext_vector_type(4)));
typedef LAS const char* lds_cptr;
typedef unsigned u32x2_t __attribute__((ext_vector_type(2)));
#define MLF_MFMA(a, b, c) __builtin_amdgcn_mfma_f32_32x32x16_bf16(a, b, c, 0, 0, 0)
__device__ __forceinline__ s16x4 vtr(lds_cptr p) { return __builtin_bit_cast(s16x4, __builtin_amdgcn_ds_read_tr16_b64_v4i16((LAS v4i16_t*)p)); }
__device__ __forceinline__ bf16x8 trfrag(lds_cptr p, int second) { const s16x4 lo = vtr(p), hh = vtr(p + second); return (bf16x8){lo[0], lo[1], lo[2], lo[3], hh[0], hh[1], hh[2], hh[3]}; }
__device__ __forceinline__ int crow(int r, int hi) { return (r & 3) + 8 * (r >> 2) + 4 * hi; }

constexpr int PL_WQ = 0, PL_WK = 32768, PL_CV = 65536, PL_XC = 67584;
__device__ __forceinline__ void prep_load_head(const P& p, LAS unsigned char* shm, int h) {
    const int tid = threadIdx.x;
    const bf16_t* WQT = (const bf16_t*)(p.ws + WS_MWQ) + (size_t)h * 16384;
#pragma unroll
    for (int i = 0; i < 8; ++i) { const int idx = tid + 512 * i, mat = idx >> 11, ch = idx & 2047, e = ch >> 4, c = ch & 15;
        *(LAS u32x4_t*)(shm + mat * 32768 + e * 256 + ((c ^ (e & 15)) << 4)) = *(const u32x4_t*)(WQT + mat * 65536 + e * 128 + c * 8); }
    { const int a = tid >> 7, d = tid & 127; ((LAS float*)(shm + PL_CV))[tid] = a < 3 ? p.conv_w[a * 512 + h * 128 + d] : p.conv_b[h * 128 + d]; }
}
struct PrepX { u32x4_t x0[4], x1[4], x2[4]; float mp, mn; };
__device__ __forceinline__ void prep_loadx(const P& p, int c, int h, PrepX& X) {
    const int tid = threadIdx.x, lane = tid & 63, r32 = lane & 31, hi = lane >> 5; const int wid = __builtin_amdgcn_readfirstlane(tid >> 6);
    const int tq = wid & 3, eh = wid >> 2;
    const bool lat = c < 256; const int row0 = lat ? c * 128 : R + (c - 256) * 128;
    const int row = row0 + 32 * tq + r32; const int L = lat ? SEQ : CTX; const int t = (lat ? row : row - R) & (L - 1);
    const char* XM = (const char*)(p.ws + WS_XM) + (unsigned)(row * 1024 + h * 256 + 16 * hi);
    X.mp = t > 0 ? 1.f : 0.f; X.mn = t < L - 1 ? 1.f : 0.f; const int op = t > 0 ? -1024 : 0, on = t < L - 1 ? 1024 : 0;
#pragma unroll
    for (int k4 = 0; k4 < 4; ++k4) { const int ks = 4 * eh + k4; X.x1[k4] = *(const u32x4_t*)(XM + 32 * ks); X.x0[k4] = *(const u32x4_t*)(XM + op + 32 * ks); X.x2[k4] = *(const u32x4_t*)(XM + on + 32 * ks); }
}
__device__ __forceinline__ void prep_unit(const P& p, LAS unsigned char* shm, int c, int h, PrepX& X, int cn, int hn) {
    const int tid = threadIdx.x, lane = tid & 63, r32 = lane & 31, hi = lane >> 5; const int wid = __builtin_amdgcn_readfirstlane(tid >> 6);
    const int tq = wid & 3, eh = wid >> 2;
    const bool lat = c < 256; const int row0 = lat ? c * 128 : R + (c - 256) * 128;
    const int row = row0 + 32 * tq + r32;
    const LAS float* cv = (const LAS float*)(shm + PL_CV) + 8 * hi;
    const lds_cptr wq = (lds_cptr)shm + PL_WQ + (64 * eh + r32) * 256, wk = (lds_cptr)shm + PL_WK + (64 * eh + r32) * 256;
    f32x16 aq[2], ak[2]; aq[0] = f32x16{}; aq[1] = f32x16{}; ak[0] = f32x16{}; ak[1] = f32x16{};
    LAS unsigned char* xcl = shm + PL_XC + tq * 8192 + lane * 16;
#pragma unroll
    for (int k4 = 0; k4 < 4; ++k4) { const int ks = 4 * eh + k4;
        float x0[8], x1[8], x2[8], w0[8], w1[8], w2[8], bb[8];
        ml::f8(X.x0[k4], x0); ml::f8(X.x1[k4], x1); ml::f8(X.x2[k4], x2);
#pragma unroll
        for (int q = 0; q < 2; ++q) { const f32x4 a = *(const LAS f32x4*)(cv + 16 * ks + 4 * q), b = *(const LAS f32x4*)(cv + 128 + 16 * ks + 4 * q), cc = *(const LAS f32x4*)(cv + 256 + 16 * ks + 4 * q), d = *(const LAS f32x4*)(cv + 384 + 16 * ks + 4 * q);
#pragma unroll
            for (int i = 0; i < 4; ++i) { w0[4 * q + i] = a[i]; w1[4 * q + i] = b[i]; w2[4 * q + i] = cc[i]; bb[4 * q + i] = d[i]; } }
        float y[8];
#pragma unroll
        for (int i = 0; i < 8; ++i) { const float a = bb[i] + w0[i] * (x0[i] * X.mp) + w1[i] * x1[i] + w2[i] * (x2[i] * X.mn); y[i] = a * ep::fsig(a); }
        u32x4_t xw; xw.x = pg8::cvt_pk_bf16(y[0], y[1]); xw.y = pg8::cvt_pk_bf16(y[2], y[3]); xw.z = pg8::cvt_pk_bf16(y[4], y[5]); xw.w = pg8::cvt_pk_bf16(y[6], y[7]);
        *(LAS u32x4_t*)(xcl + ks * 1024) = xw;
    }
    asm volatile("s_waitcnt lgkmcnt(0)\n\ts_barrier" ::: "memory");
    if (cn >= 0) prep_loadx(p, cn, hn, X);
#pragma unroll
    for (int ks = 0; ks < 8; ++ks) {
        const bf16x8 xf = *(const LAS bf16x8*)(xcl + ks * 1024);
        const int sw = ((2 * ks + hi) ^ (r32 & 15)) << 4;
#pragma unroll
        for (int nb = 0; nb < 2; ++nb) {
            const bf16x8 wqf = *(const LAS bf16x8*)(wq + nb * 8192 + sw), wkf = *(const LAS bf16x8*)(wk + nb * 8192 + sw);
            aq[nb] = MLF_MFMA(wqf, xf, aq[nb]); ak[nb] = MLF_MFMA(wkf, xf, ak[nb]);
        }
    }
    char* MQ = (char*)(p.ws + WS_MQ) + (unsigned)(row * 1024 + h * 256 + 128 * eh + 8 * hi); char* MK = MQ + (WS_MK - WS_MQ);
#pragma unroll
    for (int nb = 0; nb < 2; ++nb)
#pragma unroll
        for (int g = 0; g < 4; ++g) {
            u32x2_t a, b; a.x = att::cvtpk_s(aq[nb][4 * g], aq[nb][4 * g + 1]); a.y = att::cvtpk_s(aq[nb][4 * g + 2], aq[nb][4 * g + 3]);
            b.x = att::cvtpk_s(ak[nb][4 * g], ak[nb][4 * g + 1]); b.y = att::cvtpk_s(ak[nb][4 * g + 2], ak[nb][4 * g + 3]);
            *(u32x2_t*)(MQ + 64 * nb + 16 * g) = a; *(u32x2_t*)(MK + 64 * nb + 16 * g) = b;
        }
    asm volatile("s_waitcnt lgkmcnt(0)\n\ts_barrier" ::: "memory");
}
__device__ __forceinline__ void prep_phase(Frame& F, const P& p) {
    int hl = -1; PrepX X;
    if (F.vcu < 1152) prep_loadx(p, F.vcu >> 2, F.vcu & 3, X);
    for (int u = F.vcu; u < 1152; u += F.G) { const int h = u & 3;
        if (h != hl) { __syncthreads(); prep_load_head(p, F.lds + RING_OFF, h); __syncthreads(); hl = h; }
        const int un = u + F.G;
        prep_unit(p, F.lds + RING_OFF, u >> 2, h, X, un < 1152 ? (un >> 2) : -1, un & 3); }
    __syncthreads();
}

constexpr int L_KT = 0  , L_VP = 65536, L_CB = 90112, L_GT = 106496  , L_NV = 112128;
constexpr int GT_WROW = 0, GT_MU2 = 512, GT_DEC = 1024, GT_CLAMP = 1536, GT_WGT = 2048, GT_CARRY = 2560, GT_STRIDE = 2816;
constexpr float LOG2E = 1.4426950408889634f;
__device__ __forceinline__ void glds16(const void* gsrc, unsigned lds_dst) { unsigned keep;
    asm volatile("s_mov_b32 %0, m0\n\ts_mov_b32 m0, %2\n\ts_nop 0\n\tglobal_load_lds_dwordx4 %1, off\n\ts_mov_b32 m0, %0" : "=&s"(keep) : "v"(gsrc), "s"(lds_dst) : "memory"); }
#define MLF_GL16(dst, ptr) asm volatile("global_load_dwordx4 %0, %1, off" : "=v"(dst) : "v"(ptr) : "memory")

#ifndef TPROBE
#define TPROBE 0
#endif
#define TP_ON(k) if (TPROBE == (k)) tp_t0 = __builtin_amdgcn_s_memrealtime()
#define TP_OFF(k) if (TPROBE == (k)) tp_acc += __builtin_amdgcn_s_memrealtime() - tp_t0
template <bool NOMEM> __device__ __forceinline__ void chain_unit(const P& p, LAS unsigned char* shm, int u) {
    unsigned long long tp_t0 = 0, tp_acc = 0; TP_ON(1);
    const int tid = threadIdx.x, lane = tid & 63, r32 = lane & 31, hi = lane >> 5; const int wid = __builtin_amdgcn_readfirstlane(tid >> 6);
    const int vh = u & 1, dir = (u >> 1) & 1, h = (u >> 2) & 3, b = u >> 4;
    const bf16_t* MQ = (const bf16_t*)(p.ws + WS_MQ) + h * 128; const bf16_t* MK = (const bf16_t*)(p.ws + WS_MK) + h * 128; const bf16_t* VM = (const bf16_t*)(p.ws + WS_VM) + h * 128 + 64 * vh;
    const float* GG = (const float*)(p.ws + WS_GATES) + dir * 8 + h;
    bf16_t* HO = (bf16_t*)(p.ws + (dir ? WS_HB : WS_HF)) + h * 128 + 64 * vh;
    const unsigned lds0 = (unsigned)(uintptr_t)shm; const lds_cptr shm3 = (lds_cptr)shm;
    const int trofs = ((lane >> 4) & 1) * 32 + (lane & 3) * 8;
    const int tr_perm = trofs + (4 * hi + ((lane & 15) >> 2)) * 64;
    const int tr_nat = trofs + (8 * hi + ((lane & 15) >> 2)) * 64;
    const int krow = (r32 >> 4) * 1024 + (r32 & 15) * 64 + 16 * hi;
    const int sgn = dir ? -1 : 1;
#define MLF_RSTART(j) ((j) < 2 ? R + b * CTX + (dir ? (CTX - 1 - 128 * (j)) : (128 * (j))) : b * SEQ + (dir ? (SEQ - 1 - 128 * ((j) - 2)) : (128 * ((j) - 2))))
#define MLF_AT(base, rowi, colb) ((const char*)(base) + (unsigned)((rowi) * 1024 + (colb)))
#define MLF_DMA_K(j) do { if (NOMEM) break; const int rs_ = MLF_RSTART(j); \
        _Pragma("unroll") for (int i_ = 0; i_ < 4; ++i_) { const int pc_ = 4 * wid + i_, eb_ = pc_ >> 3, sg_ = pc_ & 7; \
            glds16(MLF_AT(MK, rs_ + sgn * (16 * sg_ + (lane >> 2)), 64 * eb_ + (lane & 3) * 16), (unsigned)__builtin_amdgcn_readfirstlane(lds0 + L_KT + ((j) & 1) * 32768 + pc_ * 1024)); } } while (0)
#define MLF_GLOAD(j) do { if (NOMEM) break; const int rs_ = MLF_RSTART(j); \
        const float* g0_ = (const float*)((const char*)GG + (unsigned)((rs_ + sgn * (2 * lane)) * 64)); const float* g1_ = (const float*)((const char*)GG + (unsigned)((rs_ + sgn * (2 * lane + 1)) * 64)); \
        graw[0] = g0_[0]; graw[1] = g0_[4]; graw[2] = g1_[0]; graw[3] = g1_[4]; } while (0)
#define MLF_GATES(j) do { LAS float* gt_ = (LAS float*)(shm + L_GT + ((j) & 1) * GT_STRIDE); \
        const float i0_ = graw[0], f0_ = graw[1], i1_ = graw[2], f1_ = graw[3]; \
        float cs_ = f0_ + f1_; _Pragma("unroll") for (int o_ = 1; o_ < 64; o_ <<= 1) { const float t_ = __shfl_up(cs_, o_); if (lane >= o_) cs_ += t_; } \
        const float c1_ = cs_, c0_ = cs_ - f1_; const float a0_ = i0_ - c0_, a1_ = i1_ - c1_; \
        float mx_ = fmaxf(a0_, a1_); _Pragma("unroll") for (int o_ = 1; o_ < 64; o_ <<= 1) { const float t_ = __shfl_up(mx_, o_); if (lane >= o_) mx_ = fmaxf(mx_, t_); } \
        float pm_ = __shfl_up(mx_, 1); if (lane == 0) pm_ = -3.0e38f; \
        const float mu0_ = fmaxf(mst, fmaxf(pm_, a0_)), mu1_ = fmaxf(mst, mx_); \
        const float muend_ = __shfl(mu1_, 63), ftot_ = __shfl(c1_, 63); \
        typedef float f2_ __attribute__((ext_vector_type(2))); \
        ((LAS f2_*)(gt_ + GT_WROW / 4))[lane] = (f2_){__expf(muend_ - mu0_), __expf(muend_ - mu1_)}; \
        ((LAS f2_*)(gt_ + GT_DEC / 4))[lane] = (f2_){__expf(mst - mu0_), __expf(mst - mu1_)}; ((LAS f2_*)(gt_ + GT_CLAMP / 4))[lane] = (f2_){__expf(-(c0_ + mu0_)), __expf(-(c1_ + mu1_))}; \
        ((LAS f2_*)(gt_ + GT_WGT / 4))[lane] = (f2_){__expf(a0_ - muend_), __expf(a1_ - muend_)}; if (lane == 0) gt_[GT_CARRY / 4] = __expf(mst - muend_); \
        mst = ftot_ + muend_; } while (0)
    float mst = 0.f;
    __syncthreads();
    for (int i = tid; i < 16384 / 16; i += 512) *(LAS u32x4_t*)(shm + L_CB + i * 16) = (u32x4_t){0u, 0u, 0u, 0u};
    for (int i = tid; i < 8192 / 16; i += 512) *(LAS u32x4_t*)(shm + L_VP + 16384 + i * 16) = (u32x4_t){0u, 0u, 0u, 0u};
    if (tid < 128) ((LAS float*)(shm + L_NV))[tid] = 0.f;
    float graw[4] = {0.f, 0.f, 0.f, 0.f};
    if (wid == 0) { MLF_GLOAD(0); MLF_GATES(0); MLF_GLOAD(1); }
    MLF_DMA_K(0); MLF_DMA_K(1);
#define MLF_BAR_A() asm volatile("s_waitcnt lgkmcnt(0)\n\ts_barrier" ::: "memory")
#define MLF_BAR_B(N) asm volatile("s_waitcnt vmcnt(" #N ") lgkmcnt(0)\n\ts_barrier" ::: "memory")
    MLF_BAR_B(0);
    if (wid < 4) {
        const int tq = wid;
        f32x16 S[4]; S[0] = f32x16{}; S[1] = f32x16{}; S[2] = f32x16{}; S[3] = f32x16{};
#define PWSET(st, kk, k, val) S[2 + ((st) >> 1)][((st) & 1) * 8 + (kk) * 4 + (k)] = __uint_as_float(val)
#define PWGET(st, kk) __builtin_bit_cast(bf16x8, (f32x4){S[2 + ((st) >> 1)][((st) & 1) * 8 + (kk) * 4], S[2 + ((st) >> 1)][((st) & 1) * 8 + (kk) * 4 + 1], S[2 + ((st) >> 1)][((st) & 1) * 8 + (kk) * 4 + 2], S[2 + ((st) >> 1)][((st) & 1) * 8 + (kk) * 4 + 3]})
        u32x4_t qf[8];
#pragma unroll
        for (int ks = 0; ks < 8; ++ks) qf[ks] = (u32x4_t){0u, 0u, 0u, 0u};
        for (int j = 0; j < 18; ++j) {
            int rs = MLF_RSTART(j); asm volatile("" : "+s"(rs));
            const LAS float* gt = (const LAS float*)(shm + L_GT + (j & 1) * GT_STRIDE);
            float dq = 0.f;
            TP_ON(2);
            if (j >= 2) {
                const float wrow = gt[GT_WROW / 4 + 32 * tq + r32];
                const lds_cptr kt = shm3 + L_KT + (j & 1) * 32768 + krow;
                const lds_cptr cb = shm3 + L_CB + tr_nat;
                s16x4 tc0[16], tc1[16];
#pragma unroll
                for (int ks = 0; ks < 8; ++ks) { tc0[2 * ks] = vtr(cb + ks * 1024); tc0[2 * ks + 1] = vtr(cb + ks * 1024 + 256); }
                bf16x8 kf[8];
#pragma unroll
                for (int ks = 0; ks < 8; ++ks) kf[ks] = *(const LAS bf16x8*)(kt + (ks >> 1) * 8192 + (ks & 1) * 32);
                __builtin_amdgcn_sched_barrier(0);
#pragma unroll
                for (int st = 0; st < 4; ++st) if (st <= tq) {
                    f32x16 X = f32x16{};
#pragma unroll
                    for (int ks = 0; ks < 8; ++ks) X = MLF_MFMA(kf[ks], __builtin_bit_cast(bf16x8, qf[ks]), X);
                    if (st < tq) {
#pragma unroll
                        for (int ks = 0; ks < 8; ++ks) kf[ks] = *(const LAS bf16x8*)(kt + (st + 1) * 2048 + (ks >> 1) * 8192 + (ks & 1) * 32); }
                    X = X * wrow;
                    if (st == tq) {
#pragma unroll
                        for (int r = 0; r < 16; ++r) if (crow(r, hi) > r32) X[r] = 0.f; }
#pragma unroll
                    for (int k = 0; k < 4; ++k) { PWSET(st, 0, k, att::cvtpk_s(X[2 * k], X[2 * k + 1])); PWSET(st, 1, k, att::cvtpk_s(X[8 + 2 * k], X[9 + 2 * k])); }
                }
                const float decs = gt[GT_DEC / 4 + 32 * tq + r32];
#pragma unroll
                for (int ks = 0; ks < 8; ++ks) { tc1[2 * ks] = vtr(cb + 8192 + ks * 1024); tc1[2 * ks + 1] = vtr(cb + 8192 + ks * 1024 + 256); }
                __builtin_amdgcn_sched_barrier(0);
                { f32x16 a = f32x16{};
#pragma unroll
                  for (int ks = 0; ks < 8; ++ks) { const s16x4 lo = tc0[2 * ks], hh = tc0[2 * ks + 1]; a = MLF_MFMA(((bf16x8){lo[0], lo[1], lo[2], lo[3], hh[0], hh[1], hh[2], hh[3]}), __builtin_bit_cast(bf16x8, qf[ks]), a); }
                  S[0] = a * decs; }
                { f32x16 a = f32x16{};
#pragma unroll
                  for (int ks = 0; ks < 8; ++ks) { const s16x4 lo = tc1[2 * ks], hh = tc1[2 * ks + 1]; a = MLF_MFMA(((bf16x8){lo[0], lo[1], lo[2], lo[3], hh[0], hh[1], hh[2], hh[3]}), __builtin_bit_cast(bf16x8, qf[ks]), a); }
                  S[1] = a * decs; }
                const LAS float* nv = (const LAS float*)(shm + L_NV);
                float qn = 0.f;
#pragma unroll
                for (int ks = 0; ks < 8; ++ks) { float qv[8]; ml::f8(qf[ks], qv); const f32x4 n0 = *(const LAS f32x4*)(nv + 16 * ks + 8 * hi), n1 = *(const LAS f32x4*)(nv + 16 * ks + 8 * hi + 4);
                    qn += (qv[0] * n0[0] + qv[1] * n0[1]) + (qv[2] * n0[2] + qv[3] * n0[3]) + (qv[4] * n1[0] + qv[5] * n1[1]) + (qv[6] * n1[2] + qv[7] * n1[3]); }
                { auto rr = __builtin_amdgcn_permlane32_swap(__float_as_uint(qn), __float_as_uint(qn), false, false); qn = __uint_as_float(rr[0]) + __uint_as_float(rr[1]); }
                dq = decs * qn;
            }
            if (wid == 0 && j + 1 < 18) MLF_GATES(j + 1);
            TP_OFF(2); TP_ON(3);
            MLF_BAR_A();
            TP_OFF(3); TP_ON(4);
            if (!NOMEM && j + 1 >= 2 && j + 1 < 18) { const char* qp = MLF_AT(MQ, MLF_RSTART(j + 1) + sgn * (32 * tq + r32), 16 * hi);
#pragma unroll
                for (int ks = 0; ks < 8; ++ks) qf[ks] = *(const u32x4_t*)(qp + 32 * ks); }
            if (wid == 0 && j + 2 < 18) MLF_GLOAD(j + 2);
            if (j >= 2) {
                const lds_cptr vv = shm3 + L_VP + tr_perm;
                char* hop = (char*)HO + (unsigned)((rs + sgn * (32 * tq + r32)) * 1024 + 8 * hi);
                f32x16 accd = f32x16{};
#pragma unroll
                for (int sp = 0; sp < 2; ++sp) if (2 * sp <= tq) {
                    s16x4 tv[24];
#pragma unroll
                    for (int s2 = 0; s2 < 2; ++s2) if (2 * sp + s2 <= tq)
#pragma unroll
                        for (int kk = 0; kk < 2; ++kk)
#pragma unroll
                            for (int db = 0; db < 3; ++db) { const int sg = 2 * (2 * sp + s2) + kk, i = ((s2 * 2 + kk) * 3 + db) * 2; tv[i] = vtr(vv + db * 8192 + sg * 1024); tv[i + 1] = vtr(vv + db * 8192 + sg * 1024 + 512); }
                    __builtin_amdgcn_sched_barrier(0);
#pragma unroll
                    for (int s2 = 0; s2 < 2; ++s2) if (2 * sp + s2 <= tq)
#pragma unroll
                        for (int kk = 0; kk < 2; ++kk) { const bf16x8 pf = PWGET(2 * sp + s2, kk);
#pragma unroll
                            for (int db = 0; db < 3; ++db) { const int i = ((s2 * 2 + kk) * 3 + db) * 2; const bf16x8 vf8 = (bf16x8){tv[i][0], tv[i][1], tv[i][2], tv[i][3], tv[i + 1][0], tv[i + 1][1], tv[i + 1][2], tv[i + 1][3]};
                                if (db == 2) accd = MLF_MFMA(vf8, pf, accd); else S[db] = MLF_MFMA(vf8, pf, S[db]); } }
                    __builtin_amdgcn_sched_barrier(0);
                }
                float dsum = hi == 0 ? accd[0] : 0.f;
                { auto rr = __builtin_amdgcn_permlane32_swap(__float_as_uint(dsum), __float_as_uint(dsum), false, false); dsum = __uint_as_float(rr[0]) + __uint_as_float(rr[1]); }
                const float hinv = __builtin_amdgcn_rcpf(fmaxf(fabsf(dsum + dq), gt[GT_CLAMP / 4 + 32 * tq + r32]));
#pragma unroll
                for (int db = 0; db < 2; ++db) {
                    const f32x16 acc = S[db] * hinv;
#pragma unroll
                    for (int g = 0; g < 4; ++g) { u32x2_t w; w.x = att::cvtpk_s(acc[4 * g], acc[4 * g + 1]); w.y = att::cvtpk_s(acc[4 * g + 2], acc[4 * g + 3]); if (!NOMEM) *(u32x2_t*)(hop + 64 * db + 16 * g) = w; else asm volatile("" :: "v"(w)); }
                }
            }
            TP_OFF(4); TP_ON(5);
            MLF_BAR_B(8);
            TP_OFF(5);
            if (j + 2 < 18) MLF_DMA_K(j + 2);
        }
    } else {
        const int et = wid - 4;
        f32x16 C[3]; C[0] = f32x16{}; C[1] = f32x16{}; C[2] = f32x16{};
        const int t4 = tid - 256; const int vs = t4 >> 1, vdb = t4 & 1;
        u32x4_t vf[4];
        if (!NOMEM) { const char* vp = MLF_AT(VM, MLF_RSTART(0) + sgn * vs, 64 * vdb);
#pragma unroll
          for (int c = 0; c < 4; ++c) vf[c] = *(const u32x4_t*)(vp + 16 * c); }
        else { vf[0] = vf[1] = vf[2] = vf[3] = (u32x4_t){0u, 0u, 0u, 0u}; }
        for (int j = 0; j < 18; ++j) {
            const LAS float* gt = (const LAS float*)(shm + L_GT + (j & 1) * GT_STRIDE);
            TP_ON(6);
            { const float wg = gt[GT_WGT / 4 + vs];
              LAS unsigned char* dst = shm + L_VP + vdb * 8192 + (vs >> 4) * 1024 + (vs & 15) * 64;
#pragma unroll
              for (int c = 0; c < 4; ++c) { float v[8]; ml::f8(vf[c], v);
                  u32x4_t w; w.x = pg8::cvt_pk_bf16(v[0] * wg, v[1] * wg); w.y = pg8::cvt_pk_bf16(v[2] * wg, v[3] * wg); w.z = pg8::cvt_pk_bf16(v[4] * wg, v[5] * wg); w.w = pg8::cvt_pk_bf16(v[6] * wg, v[7] * wg);
                  *(LAS u32x4_t*)(dst + 16 * c) = w; }
              if (vdb == 0) *(LAS bf16_t*)(shm + L_VP + 16384 + (vs >> 4) * 1024 + (vs & 15) * 64) = f2bf(wg); }
            TP_OFF(6); TP_ON(8);
            MLF_BAR_A();
            TP_OFF(8); TP_ON(7);
            if (!NOMEM && j + 1 < 18) { const char* vp = MLF_AT(VM, MLF_RSTART(j + 1) + sgn * vs, 64 * vdb);
#pragma unroll
                for (int c = 0; c < 4; ++c) vf[c] = *(const u32x4_t*)(vp + 16 * c); }
            const float carry = gt[GT_CARRY / 4];
            const lds_cptr ka = shm3 + L_KT + (j & 1) * 32768 + et * 8192 + tr_perm; const lds_cptr vb = shm3 + L_VP + tr_perm;
#pragma unroll
            for (int db = 0; db < 3; ++db)
#pragma unroll
                for (int r = 0; r < 16; ++r) C[db][r] *= carry;
#pragma unroll
            for (int half = 0; half < 2; ++half) {
                s16x4 ta[8], tb[24];
#pragma unroll
                for (int k4 = 0; k4 < 4; ++k4) { const int ks = 4 * half + k4; ta[2 * k4] = vtr(ka + ks * 1024); ta[2 * k4 + 1] = vtr(ka + ks * 1024 + 512);
#pragma unroll
                    for (int db = 0; db < 3; ++db) { tb[6 * k4 + 2 * db] = vtr(vb + db * 8192 + ks * 1024); tb[6 * k4 + 2 * db + 1] = vtr(vb + db * 8192 + ks * 1024 + 512); } }
                __builtin_amdgcn_sched_barrier(0);
#pragma unroll
                for (int k4 = 0; k4 < 4; ++k4) { const bf16x8 af = (bf16x8){ta[2 * k4][0], ta[2 * k4][1], ta[2 * k4][2], ta[2 * k4][3], ta[2 * k4 + 1][0], ta[2 * k4 + 1][1], ta[2 * k4 + 1][2], ta[2 * k4 + 1][3]};
#pragma unroll
                    for (int db = 0; db < 3; ++db) { const s16x4 lo = tb[6 * k4 + 2 * db], hh = tb[6 * k4 + 2 * db + 1];
                        C[db] = MLF_MFMA(((bf16x8){lo[0], lo[1], lo[2], lo[3], hh[0], hh[1], hh[2], hh[3]}), af, C[db]); } }
                __builtin_amdgcn_sched_barrier(0);
            }
            { const int e = 32 * et + r32; LAS unsigned char* cbn = shm + L_CB + (e >> 4) * 1024 + (e & 15) * 64 + 8 * hi;
#pragma unroll
              for (int db = 0; db < 2; ++db)
#pragma unroll
                  for (int g = 0; g < 4; ++g) { u32x2_t w; w.x = att::cvtpk_s(C[db][4 * g], C[db][4 * g + 1]); w.y = att::cvtpk_s(C[db][4 * g + 2], C[db][4 * g + 3]); *(LAS u32x2_t*)(cbn + db * 8192 + 16 * g) = w; }
              if (hi == 0) ((LAS float*)(shm + L_NV))[e] = C[2][0]; }
            TP_OFF(7); TP_ON(9);
            MLF_BAR_B(4);
            TP_OFF(9);
            if (j + 2 < 18) MLF_DMA_K(j + 2);
        }
    }
    asm volatile("s_waitcnt vmcnt(0) lgkmcnt(0)\n\ts_barrier" ::: "memory");
    TP_OFF(1);
    if (TPROBE) { const unsigned long long s0 = __builtin_amdgcn_s_memrealtime(); while (__builtin_amdgcn_s_memrealtime() - s0 < tp_acc) __builtin_amdgcn_s_sleep(1); asm volatile("s_barrier" ::: "memory"); }
#undef MLF_BAR_A
#undef MLF_BAR_B
#undef PWSET
#undef PWGET
#undef MLF_DMA_K
#undef MLF_AT
#undef MLF_GATES
#undef MLF_GLOAD
#undef MLF_RSTART
}
__device__ __forceinline__ void chain_phase(Frame& F, const P& p) {
#if (PROBE_DUP >> 10) & 1
    for (int u = F.vcu; u < 256; u += F.G) chain_unit<true>(p, F.lds + RING_OFF, u);
#endif
    for (int u = F.vcu; u < 256; u += F.G) chain_unit<false>(p, F.lds + RING_OFF, u); }
}

#ifndef PROBE_DUP
#define PROBE_DUP 0
#endif
__device__ __forceinline__ int reps_of(int k) { int r = ((PROBE_DUP >> k) & 1) ? 2 : 1; if (PROBE_DUP) asm volatile("" : "+s"(r)); return r; }
#define REPS(k) reps_of(k)
struct Args { P p; int ph_lo, ph_hi, li, pad; };
__global__ void __launch_bounds__(NWAVES * 64, 2) skel_fwd(Args args) {
    extern __shared__ __attribute__((aligned(16))) unsigned char lds[];
    Frame F;
    F.lds = (LAS unsigned char*)lds;
    F.MISC = (volatile LAS unsigned*)(F.lds + MISC_OFF);
    F.tid = threadIdx.x; F.lane = F.tid & 63; F.wave = __builtin_amdgcn_readfirstlane(F.tid >> 6);
    F.G = gridDim.x; { const int bx = blockIdx.x; F.vcu = (F.G % 8 == 0) ? (bx % 8) * (F.G / 8) + bx / 8 : bx; }
    const P& p = args.p;
    F.ctl = (gu32*)(p.ws + WS_CTL);
    for (int u = F.tid; u < (LDS_BYTES - LDSCTL_OFF) / 4; u += NWAVES * 64) ((LAS unsigned*)(F.lds + LDSCTL_OFF))[u] = 0u;
    __syncthreads();
    const int lo = args.ph_lo, hi = args.ph_hi;
    XcdBarrier bar = xcd_barrier_post((unsigned*)(F.ctl + CW_BAR) + args.li * XCD_BAR_WORDS, F.MISC + 8);
#define IN(k) (lo <= (k) && (k) < hi)
#define BOTH(k) (IN(k) && (k) + 1 < hi)
#define GRID_BAR() xcd_barrier(bar)
    if (IN(0)) { for (int rep = 0; rep < REPS(0); ++rep) p0_prologue(F, p); if (BOTH(0)) GRID_BAR(); }
    if (IN(1)) { for (int rep = 0; rep < REPS(1); ++rep) { p1_hrows(F, p); p_transposes(F, p); } if (BOTH(1)) GRID_BAR(); }
#if (PROBE_DUP >> 9) & 1
    for (int rep = 0; rep < 16; ++rep) GRID_BAR();
#endif
    if (IN(2)) {
        pg8::Gemm g{(const bf16_t*)(p.ws + WS_H), (const bf16_t*)(p.ws + WS_WTIN), nullptr, nullptr, 1024};
        ep::SchedIn S; S.init(F.G, (int)blockIdx.x);
        ep::EpiIn E{p.ws, p.q_g, p.k_g, p.b_if};
        pg8::gemm_phase<ep::EpiIn, ep::SchedIn, true, true>(F.lds + RING_OFF, g, S, E);
        if (BOTH(2)) GRID_BAR();
    }
    if (IN(3)) { for (int rep = 0; rep < REPS(3); ++rep) att::attn_phase(F, p, rep + 1 < REPS(3)); for (int rep = 0; rep < REPS(8); ++rep) mlf::prep_phase(F, p); if (BOTH(3)) GRID_BAR(); }
    if (IN(4)) { for (int rep = 0; rep < REPS(4); ++rep) mlf::chain_phase(F, p); if (BOTH(4)) GRID_BAR(); }
    if (IN(5)) { for (int rep = 0; rep < REPS(5); ++rep) ml::finish_phase(F, p); if (BOTH(5)) GRID_BAR(); }
    if (IN(6)) {
        pg8::Gemm g{(const bf16_t*)(p.ws + WS_Q), (const bf16_t*)(p.ws + WS_WTOA), (const bf16_t*)(p.ws + WS_YB), (const bf16_t*)(p.ws + WS_WTOB), 512};
        ep::SchedMerge S; S.init(F.G, (int)blockIdx.x);
        ep::EpiMerge E{(bf16_t*)(p.ws + WS_GA), (bf16_t*)(p.ws + WS_GB)};
        pg8::gemm_phase<ep::EpiMerge, ep::SchedMerge, true, true>(F.lds + RING_OFF, g, S, E);
        if (BOTH(6)) GRID_BAR();
    }
    if (IN(7)) {
        pg8::Gemm g{(const bf16_t*)(p.ws + WS_GB), (const bf16_t*)(p.ws + WS_WTO), nullptr, nullptr, 1024};
        ep::SchedOut S; S.init(F.G, (int)blockIdx.x);
        ep::EpiOut E{p.x, (const float*)(p.ws + WS_MOD), p.out};
        pg8::gemm_phase<ep::EpiOut, ep::SchedOut, true, true>(F.lds + RING_OFF, g, S, E);
    }
#undef IN
#undef BOTH
#undef GRID_BAR
}

extern "C" void kernel_launch(void* const* d_in, const int* in_sizes, int n_in, void* d_out, int out_size, void* d_ws, size_t ws_size, hipStream_t stream) {
    static int grid = 0;
    if (grid == 0) {
        if (n_in != 25 || ws_size < WS_END || out_size != R * 1024) { fprintf(stderr, "kernel_launch: bad args n_in %d ws %zu out %d\n", n_in, ws_size, out_size); grid = -1; return; }
        int dev = 0, cus = 0, per_cu = 0;
        if (hipGetDevice(&dev) != hipSuccess || hipDeviceGetAttribute(&cus, hipDeviceAttributeMultiprocessorCount, dev) != hipSuccess) { grid = -1; return; }
        if (hipFuncSetAttribute((const void*)skel_fwd, hipFuncAttributeMaxDynamicSharedMemorySize, LDS_BYTES) != hipSuccess) { fprintf(stderr, "hipFuncSetAttribute failed\n"); grid = -1; return; }
        if (hipOccupancyMaxActiveBlocksPerMultiprocessor(&per_cu, (const void*)skel_fwd, NWAVES * 64, LDS_BYTES) != hipSuccess || per_cu < 1) { fprintf(stderr, "occupancy query: %d blocks per CU\n", per_cu); grid = -1; (void)hipGetLastError(); return; }
        grid = cus;
    }
    if (grid < 0) return;
    if (hipMemsetAsync((char*)d_ws + WS_CTL, 0, CTL_ZERO_BYTES, stream) != hipSuccess) return;
    Args a{};
    const float** pp = (const float**)&a.p;
    for (int i = 0; i < 25; ++i) pp[i] = (const float*)d_in[i];
    a.p.out = (float*)d_out; a.p.ws = (unsigned char*)d_ws;
    const P& p = a.p;
    a.ph_lo = 0; a.ph_hi = 8; a.li = 0;
    hipLaunchKernelGGL(skel_fwd, dim3(grid), dim3(NWAVES * 64), LDS_BYTES, stream, a);
}
```

```cpp
#include <hip/hip_runtime.h>
#include <cstdio>
#include <cstdint>
#include <cmath>

#ifndef PROBE_DUP
#define PROBE_DUP 0
#endif
typedef unsigned short bf16_t;
__device__ __forceinline__ float bf2f(bf16_t v) { return __uint_as_float(((unsigned)v) << 16); }
__device__ __forceinline__ bf16_t f2bf(float f) { unsigned u = __float_as_uint(f); return (bf16_t)((u + 0x7fffu + ((u >> 16) & 1u)) >> 16); }

constexpr int DM = 1024, NB = 16, SEQ = 2048, CTX = 256;
constexpr int R = NB * SEQ;
constexpr int RCX = NB * CTX;
constexpr int RC = R + RCX;
constexpr int INW = 6160;
constexpr int NKEY = CTX + SEQ;
constexpr float EPS = 1e-6f;
constexpr float C2 = 0.125f * 1.4426950408889634f;
constexpr float LAM_INIT = 0.2f;

constexpr size_t MiB = 1u << 20;
constexpr size_t WS_CTL = 0;
constexpr size_t WS_MOD = 1 * MiB;
constexpr size_t WS_ROPE = 1 * MiB + 256 * 1024;
constexpr size_t WS_GATES = 2 * MiB;
constexpr size_t WS_WTIN = 6 * MiB;
constexpr size_t WS_WTOA = 19 * MiB, WS_WTOB = 20 * MiB, WS_WTO = 21 * MiB, WS_MWQ = 23 * MiB;
constexpr size_t WS_H = 24 * MiB;
constexpr size_t WS_MQ = 24 * MiB, WS_MK = 60 * MiB;
constexpr size_t WS_Q = 96 * MiB;
constexpr size_t WS_K = 128 * MiB;
constexpr size_t WS_V = 164 * MiB;
constexpr size_t WS_HF = WS_K, WS_HB = WS_V;
constexpr size_t WS_ZA = 200 * MiB;
constexpr size_t WS_YB = WS_ZA;
constexpr size_t WS_XM = 232 * MiB;
constexpr size_t WS_VM = 268 * MiB;
constexpr size_t WS_ZB = 304 * MiB;
constexpr size_t WS_OB = 336 * MiB;
constexpr size_t WS_GA = 368 * MiB;
constexpr size_t WS_GB = 432 * MiB;
constexpr size_t WS_END = 496 * MiB;

struct P {
    const float *x, *c, *ctx, *c_ctx, *norm_w, *w_mod, *b_mod, *w_in, *b_if, *q_g, *k_g, *lq1, *lk1, *lq2, *lk2, *head_g, *w_out_a,
        *conv_w, *conv_b, *wq, *wk, *ml_head_g, *ml_skip, *w_out_b, *w_o;
    float* out; unsigned char* ws;
};

__device__ __forceinline__ float siluf(float v) { return v / (1.f + expf(-v)); }
__device__ __forceinline__ float sigmf(float v) { return 1.f / (1.f + expf(-v)); }
__device__ __forceinline__ float logsigf(float v) { return fminf(v, 0.f) - log1pf(expf(-fabsf(v))); }
__device__ __forceinline__ int jperm(int dd) { return 8 * ((dd & 15) >> 2) + 4 * (dd >> 4) + (dd & 3); }


namespace pg8 {
#define PG8_LAS __attribute__((address_space(3)))
typedef unsigned short bf16_t;
typedef short bf16x8 __attribute__((ext_vector_type(8)));
typedef float f32x4 __attribute__((ext_vector_type(4)));
typedef unsigned u32x4 __attribute__((ext_vector_type(4)));
constexpr int BM = 256, BK = 64, HALF = 128, HTB = HALF * BK * 2  , STAGE_BYTES = 8 * HTB, NXCD = 8, WGM = 8;

__host__ __device__ __forceinline__ int lds_byte(int r, int c) { const int st = (r >> 4) * 2 + (c >> 5), rr = r & 15, cc = c & 31, ob = rr * 64 + cc * 2; return st * 1024 + (ob ^ (((ob >> 9) & 1) << 5)); }
__host__ __device__ __forceinline__ void stage_rc(int b, int& R, int& C) { const int st = b / 1024, sb = b % 1024, swz = sb ^ (((sb >> 9) & 1) << 5); R = (st >> 1) * 16 + swz / 64; C = (st & 1) * 32 + (swz % 64) / 2; }
__host__ __device__ __forceinline__ int perm32(int rho) { const int n = rho >> 4, i = rho & 15; return 8 * (i >> 2) + 4 * n + (i & 3); }

struct Unit { int pm, pn, sel; };
struct Gemm { const bf16_t* A0; const bf16_t* B0; const bf16_t* A1; const bf16_t* B1; int K; };

struct StaticOrder {
    int nM, nN, nwg, G, c;
    __host__ __device__ void init(int M, int N, int G_, int c_) { nM = M / BM; nN = N / BM; nwg = nM * nN; G = G_; c = c_; }
    __host__ __device__ __forceinline__ bool next(int i, Unit& u) const {
        const long L = (long)i * G + c; const bool ok = L < nwg;
        int wgid = ok ? (int)L : 0; { const int q = nwg / NXCD, r = nwg % NXCD, xcd = wgid % NXCD, off = wgid / NXCD; wgid = (xcd < r ? xcd * (q + 1) : r * (q + 1) + (xcd - r) * q) + off; }
        const int nig = WGM * nN, gid = wgid / nig, fm = gid * WGM, gsz = (nM - fm) < WGM ? (nM - fm) : WGM;
        u.pm = fm + ((wgid % nig) % gsz); u.pn = (wgid % nig) / gsz; u.sel = 0; return ok;
    }
    __device__ __forceinline__ void a_ready(const Unit&) const {}
    __device__ __forceinline__ void done(const Unit&) const {}
};

__device__ __forceinline__ unsigned cvt_pk_bf16(float lo, float hi) { unsigned r; asm volatile("v_cvt_pk_bf16_f32 %0, %1, %2" : "=v"(r) : "v"(lo), "v"(hi)); return r; }
template <class Epi, class Sched, bool ALIGN_EPI = false, bool SP2 = false>
__device__ __forceinline__ void gemm_phase(PG8_LAS unsigned char* lds, const Gemm g, const Sched& S, const Epi& E) {
    const int tid = threadIdx.x, wid = __builtin_amdgcn_readfirstlane(tid >> 6), lane = tid & 63, wr = wid >> 2, wc = wid & 3, fr = lane & 15, fq = lane >> 4;
    const int K = g.K, nt = K / BK;
    unsigned voffA[2], voffB[2];
#pragma unroll
    for (int i = 0; i < 2; ++i) { int R, C; stage_rc(tid * 16 + i * 8192, R, C); const int Rb = Epi::PERM ? ((R & ~31) + perm32(R & 31)) : R;
        voffA[i] = (unsigned)(R * K + C) * 2u; voffB[i] = (unsigned)(Rb * K + C) * 2u; }
    const size_t kstep = (size_t)(BK * 2);
    const size_t hstep = (size_t)HALF * K * 2;
    const size_t tstep = 2 * hstep;
    const unsigned ldsw = (unsigned)wid * 1024u;
    const int aoff = lds_byte(wr * 64 + fr, fq * 8), boff = lds_byte(wc * 32 + fr, fq * 8);
#define PG8_SA(b, h) (((b) * 2 + (h)) * HTB)
#define PG8_SB(b, h) ((4 + (b) * 2 + (h)) * HTB)
#define PG8_STAGE(bufoff, gbase, voff) do { _Pragma("unroll") for (int _i = 0; _i < 2; ++_i) \
        __builtin_amdgcn_global_load_lds((const unsigned*)((const char*)(gbase) + (voff)[_i]), (PG8_LAS unsigned*)(lds + (bufoff) + ldsw + _i * 8192), 16, 0, 0); } while (0)
#define PG8_LDA(dst, b, h) do { _Pragma("unroll") for (int m = 0; m < 4; ++m) _Pragma("unroll") for (int k = 0; k < 2; ++k) dst[m][k] = *(const PG8_LAS bf16x8*)(lds + PG8_SA(b, h) + aoff + m * 2048 + k * 1024); } while (0)
#define PG8_LDB(dst, b, h) do { _Pragma("unroll") for (int n = 0; n < 2; ++n) _Pragma("unroll") for (int k = 0; k < 2; ++k) dst[n][k] = *(const PG8_LAS bf16x8*)(lds + PG8_SB(b, h) + boff + n * 2048 + k * 1024); } while (0)
#define PG8_MMA(ai, bj, At, Bt) do { __builtin_amdgcn_s_setprio(1); _Pragma("unroll") for (int m = 0; m < 4; ++m) _Pragma("unroll") for (int n = 0; n < 2; ++n) _Pragma("unroll") for (int k = 0; k < 2; ++k) \
        acc[ai][bj][m][n] = __builtin_amdgcn_mfma_f32_16x16x32_bf16(Bt[n][k], At[m][k], acc[ai][bj][m][n], 0, 0, 0); __builtin_amdgcn_s_setprio(0); } while (0)
#define PG8_WAIT_V(n) asm volatile("s_waitcnt vmcnt(" #n ")" ::: "memory")
#define PG8_WAIT_L(n) asm volatile("s_waitcnt lgkmcnt(" #n ")" ::: "memory")
#define PG8_BAR __builtin_amdgcn_s_barrier()
#define PG8_SCHED __builtin_amdgcn_sched_barrier(0)
    Unit cur, nxt; int ui = 0;
    if (!S.next(0, cur)) return;
    f32x4 acc[2][2][4][2];
#pragma unroll
    for (int a = 0; a < 2; ++a)
#pragma unroll
        for (int b = 0; b < 2; ++b)
#pragma unroll
            for (int m = 0; m < 4; ++m)
#pragma unroll
                for (int n = 0; n < 2; ++n) acc[a][b][m][n] = (f32x4){0.f, 0.f, 0.f, 0.f};
    bf16x8 At[4][2], B0[2][2], B1[2][2];
    const char* cA = (const char*)((cur.sel & 1) ? g.A1 : g.A0) + (size_t)cur.pm * tstep; const char* cB = (const char*)((cur.sel & 1) ? g.B1 : g.B0) + (size_t)cur.pn * tstep;
    S.a_ready(cur);
    if constexpr (SP2) {
        PG8_STAGE(PG8_SB(0, 0), cB, voffB); PG8_STAGE(PG8_SB(0, 1), cB + hstep, voffB); PG8_STAGE(PG8_SA(0, 0), cA, voffA); PG8_STAGE(PG8_SA(0, 1), cA + hstep, voffA);
        if (wr == 1) PG8_BAR;
        PG8_WAIT_V(2); PG8_BAR;
        PG8_STAGE(PG8_SB(1, 0), cB + kstep, voffB); PG8_STAGE(PG8_SA(1, 0), cA + kstep, voffA); PG8_STAGE(PG8_SB(1, 1), cB + hstep + kstep, voffB);
        PG8_WAIT_V(6); PG8_BAR;
    } else {
        PG8_STAGE(PG8_SB(0, 0), cB, voffB); PG8_STAGE(PG8_SA(0, 0), cA, voffA); PG8_STAGE(PG8_SB(0, 1), cB + hstep, voffB); PG8_STAGE(PG8_SA(0, 1), cA + hstep, voffA);
        if (wr == 1) PG8_BAR;
        PG8_WAIT_V(4); PG8_BAR;
        PG8_STAGE(PG8_SB(1, 0), cB + kstep, voffB); PG8_STAGE(PG8_SA(1, 0), cA + kstep, voffA); PG8_STAGE(PG8_SB(1, 1), cB + hstep + kstep, voffB);
        PG8_WAIT_V(6); PG8_BAR;
    }
    for (;;) {
        const bool has_next = S.next(ui + 1, nxt);
        const char* nA = has_next ? (const char*)((nxt.sel & 1) ? g.A1 : g.A0) + (size_t)nxt.pm * tstep : cA; const char* nB = has_next ? (const char*)((nxt.sel & 1) ? g.B1 : g.B0) + (size_t)nxt.pn * tstep : cB;
        for (int t = 0; t < nt; t += 2) {
            const bool last = (t == nt - 2);
            const char* a1 = cA + (size_t)(t + 1) * kstep;
            const char* a2 = last ? nA : cA + (size_t)(t + 2) * kstep; const char* b2 = last ? nB : cB + (size_t)(t + 2) * kstep;
            const char* a3 = a2 + kstep; const char* b3 = b2 + kstep;
            if (last && has_next) S.a_ready(nxt);
            if constexpr (SP2) {
            PG8_LDB(B0, 0, 0); PG8_LDB(B1, 0, 1); PG8_SCHED; PG8_LDA(At, 0, 0); PG8_STAGE(PG8_SA(1, 1), a1 + hstep, voffA);
            PG8_WAIT_V(8); PG8_WAIT_L(0); PG8_BAR; PG8_MMA(0, 0, At, B0); PG8_MMA(0, 1, At, B1); PG8_BAR; PG8_SCHED;
            PG8_LDA(At, 0, 1); PG8_STAGE(PG8_SB(0, 0), b2, voffB); PG8_STAGE(PG8_SB(0, 1), b2 + hstep, voffB); PG8_STAGE(PG8_SA(0, 0), a2, voffA);
            PG8_WAIT_V(8); PG8_WAIT_L(0); PG8_BAR; PG8_MMA(1, 0, At, B0); PG8_MMA(1, 1, At, B1); PG8_BAR; PG8_SCHED;
            PG8_LDB(B0, 1, 0); PG8_LDB(B1, 1, 1); PG8_SCHED; PG8_LDA(At, 1, 0); PG8_STAGE(PG8_SA(0, 1), a2 + hstep, voffA);
            PG8_WAIT_V(8); PG8_WAIT_L(0); PG8_BAR; PG8_MMA(0, 0, At, B0); PG8_MMA(0, 1, At, B1); PG8_BAR; PG8_SCHED;
            PG8_LDA(At, 1, 1); PG8_STAGE(PG8_SB(1, 0), b3, voffB); PG8_STAGE(PG8_SB(1, 1), b3 + hstep, voffB); PG8_STAGE(PG8_SA(1, 0), a3, voffA);
            PG8_WAIT_V(8); PG8_WAIT_L(0); PG8_BAR; PG8_MMA(1, 0, At, B0); PG8_MMA(1, 1, At, B1); PG8_BAR; PG8_SCHED;
            } else {
            PG8_LDB(B0, 0, 0); PG8_SCHED; PG8_LDA(At, 0, 0); PG8_STAGE(PG8_SA(1, 1), a1 + hstep, voffA);
            PG8_WAIT_L(8); PG8_BAR; PG8_WAIT_L(0); PG8_MMA(0, 0, At, B0); PG8_BAR; PG8_SCHED;
            PG8_LDB(B1, 0, 1); PG8_STAGE(PG8_SB(0, 0), b2, voffB);
            PG8_BAR; PG8_WAIT_L(0); PG8_MMA(0, 1, At, B1); PG8_BAR;
            PG8_LDA(At, 0, 1); PG8_STAGE(PG8_SA(0, 0), a2, voffA);
            PG8_BAR; PG8_WAIT_L(0); PG8_MMA(1, 0, At, B0); PG8_BAR; PG8_SCHED;
            PG8_STAGE(PG8_SB(0, 1), b2 + hstep, voffB);
            PG8_WAIT_V(6); PG8_BAR; PG8_MMA(1, 1, At, B1); PG8_BAR;
            PG8_LDB(B0, 1, 0); PG8_SCHED; PG8_LDA(At, 1, 0); PG8_STAGE(PG8_SA(0, 1), a2 + hstep, voffA);
            PG8_WAIT_L(8); PG8_BAR; PG8_WAIT_L(0); PG8_MMA(0, 0, At, B0); PG8_BAR; PG8_SCHED;
            PG8_LDB(B1, 1, 1); PG8_STAGE(PG8_SB(1, 0), b3, voffB);
            PG8_BAR; PG8_WAIT_L(0); PG8_MMA(0, 1, At, B1); PG8_BAR;
            PG8_LDA(At, 1, 1); PG8_STAGE(PG8_SA(1, 0), a3, voffA);
            PG8_BAR; PG8_WAIT_L(0); PG8_MMA(1, 0, At, B0); PG8_BAR; PG8_SCHED;
            PG8_STAGE(PG8_SB(1, 1), b3 + hstep, voffB);
            PG8_WAIT_V(6); PG8_BAR; PG8_MMA(1, 1, At, B1); PG8_BAR;
            }
        }
        if constexpr (ALIGN_EPI) { if (wr == 0) PG8_BAR; }
        if constexpr (!Epi::AFTER_DRAIN) { E(acc, cur, wr, wc, fr, fq); S.done(cur); }
        if (!has_next) break;
#pragma unroll
        for (int a = 0; a < 2; ++a)
#pragma unroll
            for (int b = 0; b < 2; ++b)
#pragma unroll
                for (int m = 0; m < 4; ++m)
#pragma unroll
                    for (int n = 0; n < 2; ++n) acc[a][b][m][n] = (f32x4){0.f, 0.f, 0.f, 0.f};
        cur = nxt; cA = nA; cB = nB; ++ui;
        if constexpr (ALIGN_EPI) { if (wr == 1) PG8_BAR; }
    }
    PG8_WAIT_V(0);
    if constexpr (!ALIGN_EPI) { if (wr == 0) PG8_BAR; }
    PG8_BAR;
    if constexpr (Epi::AFTER_DRAIN) { E.fused(acc, cur, wr, wc, fr, fq, lds, wid, lane); S.done(cur); }
#undef PG8_SA
#undef PG8_SB
#undef PG8_STAGE
#undef PG8_LDA
#undef PG8_LDB
#undef PG8_MMA
#undef PG8_WAIT_V
#undef PG8_WAIT_L
#undef PG8_BAR
#undef PG8_SCHED
}
}
#define GAS __attribute__((address_space(1)))
#define LAS __attribute__((address_space(3)))
typedef unsigned v4u __attribute__((ext_vector_type(4)));
typedef float f32x4 __attribute__((ext_vector_type(4)));
typedef short bf16x8 __attribute__((ext_vector_type(8)));
typedef GAS unsigned gu32;
typedef GAS unsigned long long gu64;
#define RLX_AGENT __ATOMIC_RELAXED, __HIP_MEMORY_SCOPE_AGENT
#define LDS_WAIT() asm volatile("s_waitcnt lgkmcnt(0)" ::: "memory")
#define VM_WAIT() asm volatile("s_waitcnt vmcnt(0)" ::: "memory")
__device__ __forceinline__ unsigned long long rt() { return __builtin_amdgcn_s_memrealtime(); }
__device__ __forceinline__ unsigned pk2(float lo, float hi) { return (unsigned)f2bf(lo) | ((unsigned)f2bf(hi) << 16); }

#define XB_TMO      128
#define XB_XCNT(j)  (256  + 64 * (j))
#define XB_XSUB(j)  (1280 + 64 * (j))
#define XB_XGEN(j)  (2304 + 64 * (j))
#define XB_TOP      3328
#define XB_TOPGEN   3392
#define XCD_BAR_WORDS 3456
#define XB_SPIN_CAP (1u << 22)

__device__ __forceinline__ unsigned xb_ld(unsigned* p)              { return __hip_atomic_load(p, __ATOMIC_RELAXED, __HIP_MEMORY_SCOPE_AGENT); }
__device__ __forceinline__ unsigned xb_add(unsigned* p, unsigned v) { return __hip_atomic_fetch_add(p, v, __ATOMIC_RELAXED, __HIP_MEMORY_SCOPE_AGENT); }
__device__ __forceinline__ unsigned xb_xcc_id() { return (unsigned)__builtin_amdgcn_s_getreg((3 << 11) | 20) & 0xFu; }
#define XB_SPIN(cond, bar) do { unsigned _sp = 0; while (cond) { __builtin_amdgcn_s_sleep(1); \
    if ((++_sp & 255u) == 0u) { if (xb_ld(&(bar)[XB_TMO])) break; if (_sp > XB_SPIN_CAP) { atomicAdd(&(bar)[XB_TMO], 1u); break; } } } } while (0)

struct XcdBarrier {
    unsigned* bar; unsigned x;
    volatile LAS unsigned* st;
};

__device__ __forceinline__ XcdBarrier xcd_barrier_post(unsigned* bar, volatile LAS unsigned* st) {
    XcdBarrier b; b.bar = bar; b.x = xb_xcc_id(); b.st = st;
    if (threadIdx.x == 0) (void)xb_add(&bar[XB_XCNT(b.x)], 1u);
    return b;
}
__device__ __forceinline__ void xcd_barrier_complete(unsigned* bar, unsigned x, unsigned& nloc, unsigned& nx) {
    const unsigned G = gridDim.x * gridDim.y * gridDim.z;
    unsigned sum, cnt, mine, sp = 0u;
    for (;;) {
        sum = 0u; cnt = 0u; mine = 0u;
#pragma unroll
        for (unsigned j = 0; j < 16; ++j) { const unsigned c = xb_ld(&bar[XB_XCNT(j)]); sum += c; cnt += (c > 0u) ? 1u : 0u; mine = (j == x) ? c : mine; }
        if (sum == G) break;
        __builtin_amdgcn_s_sleep(1);
        if ((++sp & 255u) == 0u) { if (xb_ld(&bar[XB_TMO])) break; if (sp > XB_SPIN_CAP) { atomicAdd(&bar[XB_TMO], 1u); break; } }
    }
    nloc = mine > 0u ? mine : 1u; nx = cnt > 0u ? cnt : 1u;
}

__device__ __forceinline__ void xcd_barrier(const XcdBarrier& b) {
    asm volatile("s_waitcnt vmcnt(0)" ::: "memory");
    __syncthreads();
    if (threadIdx.x == 0) {
        unsigned* bar = b.bar;
        __builtin_amdgcn_s_waitcnt(0);
        unsigned nloc = b.st[0], nx = b.st[1];
        if (nloc == 0u) { xcd_barrier_complete(bar, b.x, nloc, nx); b.st[0] = nloc; b.st[1] = nx; }
        const unsigned old = xb_add(&bar[XB_XSUB(b.x)], 1u);
        const unsigned gen = old / nloc;
        if (old + 1u == (gen + 1u) * nloc) {
            __builtin_amdgcn_fence(__ATOMIC_RELEASE, "agent");
            asm volatile("s_waitcnt vmcnt(0)" ::: "memory");
            const unsigned og = xb_add(&bar[XB_TOP], 1u);
            const unsigned tg = og / nx;
            if (og + 1u == (tg + 1u) * nx) xb_add(&bar[XB_TOPGEN], 1u);
            else XB_SPIN(xb_ld(&bar[XB_TOPGEN]) == tg, bar);
            __builtin_amdgcn_fence(__ATOMIC_ACQUIRE, "agent");
            xb_add(&bar[XB_XGEN(b.x)], 1u);
            asm volatile("s_waitcnt vmcnt(0)" ::: "memory");
        } else {
            XB_SPIN(xb_ld(&bar[XB_XGEN(b.x)]) == gen, bar);
            __builtin_amdgcn_fence(__ATOMIC_ACQUIRE, "agent");
            asm volatile("s_waitcnt vmcnt(0)" ::: "memory");
        }
    }
    __syncthreads();
}
namespace ep {
using pg8::f32x4; using pg8::u32x4; using pg8::Unit; using pg8::cvt_pk_bf16;
__device__ __forceinline__ float fsig(float v) { return __builtin_amdgcn_rcpf(1.f + __builtin_amdgcn_exp2f(-1.4426950408889634f * v)); }
__device__ __forceinline__ f32x4 act4(f32x4 v, int mode) {
    if (mode == 0) return v;
    f32x4 s; s[0] = fsig(v[0]); s[1] = fsig(v[1]); s[2] = fsig(v[2]); s[3] = fsig(v[3]);
    return mode == 1 ? v * s : s;
}
__device__ __forceinline__ u32x4 pack8(f32x4 a, f32x4 b) { u32x4 w; w.x = cvt_pk_bf16(a[0], a[1]); w.y = cvt_pk_bf16(a[2], a[3]); w.z = cvt_pk_bf16(b[0], b[1]); w.w = cvt_pk_bf16(b[2], b[3]); return w; }
__device__ __forceinline__ float lo16(unsigned w) { return __uint_as_float(w << 16); }
__device__ __forceinline__ float hi16(unsigned w) { return __uint_as_float(w & 0xffff0000u); }

struct EpiIn {
    static constexpr bool PERM = true, AFTER_DRAIN = false;
    unsigned char* ws; const float* q_g; const float* k_g; const float* b_if;
    __device__ __forceinline__ void operator()(const f32x4 (&acc)[2][2][4][2], const Unit& u, int wr, int wc, int fr, int fq) const {
        const int pn = u.pn; const int row0 = u.pm * 256 + wr * 64 + fr;
        if (pn < 4) {
            const bool isq = pn < 2;
            bf16_t* dst = (bf16_t*)(ws + (isq ? WS_Q : WS_K)) + (pn & 1) * 256 + 64 * wc + 8 * fq;
            const float* g = isq ? q_g : k_g;
            f32x4 gv[2][2];
#pragma unroll
            for (int bj = 0; bj < 2; ++bj)
#pragma unroll
                for (int n = 0; n < 2; ++n) gv[bj][n] = *(const f32x4*)(g + 32 * bj + 16 * n + 4 * fq);
            const float* rope = (const float*)(ws + WS_ROPE) + 4 * fq;
            const bool lat = u.pm < 128; const float sc = isq ? C2 : 1.f;
#pragma unroll
            for (int ai = 0; ai < 2; ++ai) {
                f32x4 rp4[4][4];
                if (lat) {
#pragma unroll
                    for (int m = 0; m < 4; ++m) { const int t = (row0 + ai * 128 + m * 16) & (SEQ - 1), rid = t >> 6, cid = t & 63;
                        rp4[m][0] = *(const f32x4*)(rope + rid * 16); rp4[m][1] = *(const f32x4*)(rope + 1024 + rid * 16); rp4[m][2] = *(const f32x4*)(rope + cid * 16); rp4[m][3] = *(const f32x4*)(rope + 1024 + cid * 16); }
                }
                asm volatile("" ::: "memory");
#pragma unroll
                for (int m = 0; m < 4; ++m) {
                    const int row = row0 + ai * 128 + m * 16;
                    float ss = 0.f;
#pragma unroll
                    for (int bj = 0; bj < 2; ++bj)
#pragma unroll
                        for (int n = 0; n < 2; ++n) { const f32x4 a = acc[ai][bj][m][n]; ss += (a[0] * a[0] + a[1] * a[1]) + (a[2] * a[2] + a[3] * a[3]); }
                    ss += __shfl_xor(ss, 16); ss += __shfl_xor(ss, 32);
                    const float rn = rsqrtf(ss * (1.f / 64.f) + EPS) * sc;
                    f32x4 y[2][2];
#pragma unroll
                    for (int bj = 0; bj < 2; ++bj)
#pragma unroll
                        for (int n = 0; n < 2; ++n) y[bj][n] = acc[ai][bj][m][n] * rn * gv[bj][n];
                    if (lat) {
                        const f32x4 cr = rp4[m][0], sr = rp4[m][1], cc = rp4[m][2], scn = rp4[m][3];
                        const f32x4 a0 = y[0][0] * cr - y[0][1] * sr, a1 = y[0][0] * sr + y[0][1] * cr;
                        const f32x4 b0 = y[1][0] * cc - y[1][1] * scn, b1 = y[1][0] * scn + y[1][1] * cc;
                        y[0][0] = a0; y[0][1] = a1; y[1][0] = b0; y[1][1] = b1;
                    }
                    bf16_t* rp = dst + (size_t)row * 512;
                    *(u32x4*)(rp) = pack8(y[0][0], y[0][1]);
                    *(u32x4*)(rp + 32) = pack8(y[1][0], y[1][1]);
                }
                asm volatile("" ::: "memory");
            }
        } else if (pn < 24) {
            size_t off; int ld, cb, mode;
            if (pn < 16) { ld = 512; cb = (pn & 1) * 256; const int s = pn >> 1;
                off = s == 2 ? WS_V : s == 3 ? WS_ZA : s == 4 ? WS_XM : s == 5 ? WS_VM : s == 6 ? WS_ZB : WS_OB;
                mode = (s == 3 || s == 6) ? 1 : (s == 7 ? 2 : 0); }
            else { ld = 1024; cb = ((pn - 16) & 3) * 256; off = pn < 20 ? WS_GA : WS_GB; mode = 2; }
            bf16_t* dst = (bf16_t*)(ws + off) + cb + 32 * wc + 8 * fq;
#pragma unroll
            for (int ai = 0; ai < 2; ++ai)
#pragma unroll
                for (int m = 0; m < 4; ++m) { bf16_t* rp = dst + (size_t)(row0 + ai * 128 + m * 16) * ld;
#pragma unroll
                    for (int bj = 0; bj < 2; ++bj) *(u32x4*)(rp + bj * 128) = pack8(act4(acc[ai][bj][m][0], mode), act4(acc[ai][bj][m][1], mode)); }
        } else {
            if (wc == 0 && fq < 2) {
                float* G = (float*)(ws + WS_GATES) + 8 * fq;
                const f32x4 bi = *(const f32x4*)(b_if + 8 * fq), bf = *(const f32x4*)(b_if + 8 * fq + 4);
#pragma unroll
                for (int ai = 0; ai < 2; ++ai)
#pragma unroll
                    for (int m = 0; m < 4; ++m) { float* rp = G + (size_t)(row0 + ai * 128 + m * 16) * 16;
                        const f32x4 vi = acc[ai][0][m][0] + bi; f32x4 vf = acc[ai][0][m][1] + bf;
#pragma unroll
                        for (int i = 0; i < 4; ++i) { const float x = vf[i]; vf[i] = fminf(x, 0.f) - 0.6931471805599453f * __builtin_amdgcn_logf(1.f + __builtin_amdgcn_exp2f(-1.4426950408889634f * fabsf(x))); }
                        *(f32x4*)rp = vi; *(f32x4*)(rp + 4) = vf; }
            }
        }
    }
};
struct EpiMerge {
    static constexpr bool PERM = true, AFTER_DRAIN = false;
    bf16_t* GA; bf16_t* GB;
    __device__ __forceinline__ void operator()(const f32x4 (&acc)[2][2][4][2], const Unit& u, int wr, int wc, int fr, int fq) const {
        const int row0 = u.pm * 256 + wr * 64 + fr; const int col0 = u.pn * 256 + 32 * wc + 8 * fq; const bool second = (u.sel & 1) != 0; const bool dry = (u.sel & 2) != 0;
        bf16_t* G = second ? GB : GA;
#pragma unroll
        for (int ai = 0; ai < 2; ++ai) {
            u32x4 gwv[4][2], awv[4][2];
#pragma unroll
            for (int m = 0; m < 4; ++m) { const size_t ro = (size_t)(row0 + ai * 128 + m * 16) * 1024 + col0;
#pragma unroll
                for (int bj = 0; bj < 2; ++bj) { gwv[m][bj] = *(const u32x4*)(G + ro + bj * 128); if (second) awv[m][bj] = *(const u32x4*)(GA + ro + bj * 128); } }
            asm volatile("" ::: "memory");
#pragma unroll
            for (int m = 0; m < 4; ++m) { const size_t ro = (size_t)(row0 + ai * 128 + m * 16) * 1024 + col0;
#pragma unroll
                for (int bj = 0; bj < 2; ++bj) { const size_t o = ro + bj * 128; const u32x4 gw = gwv[m][bj];
                    f32x4 g0 = {lo16(gw.x), hi16(gw.x), lo16(gw.y), hi16(gw.y)}, g1 = {lo16(gw.z), hi16(gw.z), lo16(gw.w), hi16(gw.w)};
                    f32x4 v0 = g0 * acc[ai][bj][m][0], v1 = g1 * acc[ai][bj][m][1];
                    if (second) { const u32x4 aw = awv[m][bj];
                        v0 += (f32x4){lo16(aw.x), hi16(aw.x), lo16(aw.y), hi16(aw.y)}; v1 += (f32x4){lo16(aw.z), hi16(aw.z), lo16(aw.w), hi16(aw.w)}; }
                    if (!dry) *(u32x4*)(G + o) = pack8(v0, v1); } }
            asm volatile("" ::: "memory");
        }
    }
};
struct EpiOut {
    static constexpr bool PERM = false, AFTER_DRAIN = false;
    const float* x; const float* mod; float* out;
    __device__ __forceinline__ void operator()(const f32x4 (&acc)[2][2][4][2], const Unit& u, int wr, int wc, int fr, int fq) const {
        const int row0 = u.pm * 256 + wr * 64 + fr; const int col0 = u.pn * 256 + 32 * wc + 4 * fq;
        const float* gt = mod + (size_t)(u.pm >> 3) * 3072 + 2048 + col0;
        f32x4 gv[2][2];
#pragma unroll
        for (int bj = 0; bj < 2; ++bj)
#pragma unroll
            for (int n = 0; n < 2; ++n) gv[bj][n] = *(const f32x4*)(gt + bj * 128 + n * 16);
#pragma unroll
        for (int ai = 0; ai < 2; ++ai) {
            f32x4 xv[4][2][2];
#pragma unroll
            for (int m = 0; m < 4; ++m) { const size_t ro = (size_t)(row0 + ai * 128 + m * 16) * 1024 + col0;
#pragma unroll
                for (int bj = 0; bj < 2; ++bj)
#pragma unroll
                    for (int n = 0; n < 2; ++n) xv[m][bj][n] = *(const f32x4*)(x + ro + bj * 128 + n * 16); }
            asm volatile("" ::: "memory");
#pragma unroll
            for (int m = 0; m < 4; ++m) { const size_t ro = (size_t)(row0 + ai * 128 + m * 16) * 1024 + col0;
#pragma unroll
                for (int bj = 0; bj < 2; ++bj)
#pragma unroll
                    for (int n = 0; n < 2; ++n) *(f32x4*)(out + ro + bj * 128 + n * 16) = xv[m][bj][n] + gv[bj][n] * acc[ai][bj][m][n]; }
            asm volatile("" ::: "memory");
        }
    }
};
struct SchedIn {
    pg8::StaticOrder so; int G, c;
    __device__ void init(int G_, int c_) { so.init(R, 24 * 256, G_, c_); G = G_; c = c_; }
    __device__ __forceinline__ bool next(int i, Unit& u) const {
#if defined(PROBE_DUP) && ((PROBE_DUP >> 2) & 1)
        { const int nr = (3328 + G - 1) / G; if (i >= nr) { if (i >= 2 * nr) return false; i -= nr; } }
#endif
        Unit t; const bool reg = so.next(i, t);
        const int Lp = (int)((long)i * G + c - 3072);
        const bool ok = reg || Lp < 256;
        const int idx = Lp >> 4;
        const int pm2 = Lp < 128 ? 128 + (Lp & 15) : Lp - 128;
        const int pn2 = Lp < 128 ? (idx < 4 ? 2 + idx : 4 + idx) : 24;
        u.pm = reg ? t.pm : pm2; u.pn = reg ? t.pn : pn2; u.sel = 0;
        return ok;
    }
    __device__ __forceinline__ void a_ready(const Unit&) const {}
    __device__ __forceinline__ void done(const Unit&) const {}
};
struct SchedMerge {
    pg8::StaticOrder so;
    __device__ void init(int G_, int c_) { so.init(R, 1024, G_, c_); }
    __device__ __forceinline__ bool next(int i, Unit& u) const { int dry = 0;
#if defined(PROBE_DUP) && ((PROBE_DUP >> 6) & 1)
        { const int nr = 2 * ((512 + so.G - 1) / so.G); if (i >= 2 * nr) return false; if (i < nr) dry = 2; else i -= nr; }
#endif
        Unit t; const bool ok = so.next(i >> 1, t); u.pm = t.pm; u.pn = t.pn; u.sel = (i & 1) | dry; return ok; }
    __device__ __forceinline__ void a_ready(const Unit&) const {}
    __device__ __forceinline__ void done(const Unit&) const {}
};
struct SchedOut {
    pg8::StaticOrder so; int G;
    __device__ void init(int G_, int c_) { so.init(R, 1024, G_, c_); G = G_; }
    __device__ __forceinline__ bool next(int i, Unit& u) const {
#if defined(PROBE_DUP) && ((PROBE_DUP >> 7) & 1)
        { const int nr = (512 + G - 1) / G; if (i >= nr) { if (i >= 2 * nr) return false; i -= nr; } }
#endif
        return so.next(i, u); }
    __device__ __forceinline__ void a_ready(const Unit&) const {}
    __device__ __forceinline__ void done(const Unit&) const {}
};
}

constexpr int NWAVES = 8;
constexpr int RING_OFF = 0, RING_BYTES = 131072;
constexpr int LDSCTL_OFF = 150 * 1024, MISC_OFF = LDSCTL_OFF + 320;
constexpr int LDS_BYTES = 152 * 1024;
typedef unsigned u32x4_t __attribute__((ext_vector_type(4)));
constexpr int CW_TMO = 0, CW_CODE = 1, CW_BAR = 4096;
constexpr size_t CTL_ZERO_BYTES = 256 * 1024;

struct Frame {
    LAS unsigned char* lds; volatile LAS unsigned* MISC; gu32* ctl;
    int tid, lane, wave, vcu, G;
};
__device__ __forceinline__ float wave_sum(float v) {
#pragma unroll
    for (int o = 1; o < 64; o <<= 1) v += __shfl_xor(v, o);
    return v;
}
__device__ __forceinline__ int dmap32(int j) { return 4 * (j >> 3) + (j & 3) + 16 * ((j >> 2) & 1); }
__device__ __forceinline__ void tr_item(const float* W, int ldw, int srccol0, int mode, int valid, bf16_t* WT, int Kd, int dstrow0, int k0, LAS float* scr, int lane, float scale = 1.f) {
    const int cl = lane & 31;
    float wv[32];
#pragma unroll
    for (int i = 0; i < 32; ++i) { const int kk = 2 * i + (lane >> 5); wv[i] = cl < valid ? __builtin_nontemporal_load(W + (size_t)(k0 + kk) * ldw + srccol0 + cl) : 0.f; }
#pragma unroll
    for (int i = 0; i < 32; ++i) { const int kk = 2 * i + (lane >> 5); scr[kk * 33 + cl] = wv[i] * scale; }
    LDS_WAIT(); asm volatile("" ::: "memory");
    const int c = lane & 7;
#pragma unroll
    for (int j = 0; j < 4; ++j) { const int n = (lane >> 3) + 8 * j; const int sn = mode ? dmap32(n) : n; const LAS float* s = scr + (8 * c) * 33 + sn;
        v4u o; o.x = pk2(s[0 * 33], s[1 * 33]); o.y = pk2(s[2 * 33], s[3 * 33]); o.z = pk2(s[4 * 33], s[5 * 33]); o.w = pk2(s[6 * 33], s[7 * 33]);
        *(GAS v4u*)(WT + (size_t)(dstrow0 + n) * Kd + k0 + 8 * c) = o; }
    LDS_WAIT(); asm volatile("" ::: "memory");
}
__device__ __forceinline__ void p_transposes(Frame& F, const P& p) {
    LAS float* scr = (LAS float*)(F.lds + RING_OFF + F.wave * 16384);
    const int gw = F.vcu * NWAVES + F.wave, NGW = F.G * NWAVES;
    bf16_t* WTIN = (bf16_t*)(p.ws + WS_WTIN); bf16_t* WTOA = (bf16_t*)(p.ws + WS_WTOA); bf16_t* WTOB = (bf16_t*)(p.ws + WS_WTOB); bf16_t* WTO = (bf16_t*)(p.ws + WS_WTO);
    constexpr int I_IN = 16 * 200, I_OA = 8 * 32, I_O = 16 * 32, I_M = 64, NITEMS = I_IN + 2 * I_OA + I_O + I_M;
    for (int it = gw; it < NITEMS; it += NGW) {
        int r = it;
        if (r < I_IN) { const int kb = r / 200, nb = r % 200; int src, mode = 0, valid = 32;
            if (nb < 32) { const int tile = nb >> 3, bj = (nb & 7) >> 2, wc = nb & 3; src = 256 * tile + 64 * wc + 32 * bj; mode = 1; }
            else if (nb < 128) src = 32 * nb;
            else if (nb < 192) src = 32 * nb + 16;
            else { src = 4096; valid = nb == 192 ? 16 : 0; }
            tr_item(p.w_in, INW, src, mode, valid, WTIN, 1024, 32 * nb, 64 * kb, scr, F.lane); continue; }
        r -= I_IN;
        if (r < I_OA) { tr_item(p.w_out_a, 1024, 32 * (r % 32), 0, 32, WTOA, 512, 32 * (r % 32), 64 * (r / 32), scr, F.lane); continue; }
        r -= I_OA;
        if (r < I_OA) { tr_item(p.w_out_b, 1024, 32 * (r % 32), 0, 32, WTOB, 512, 32 * (r % 32), 64 * (r / 32), scr, F.lane); continue; }
        r -= I_OA;
        if (r < I_O) { tr_item(p.w_o, 1024, 32 * (r % 32), 0, 32, WTO, 1024, 32 * (r % 32), 64 * (r / 32), scr, F.lane); continue; }
        r -= I_O;
        { const int mat = r >> 5, hh = (r >> 3) & 3, kb = (r >> 2) & 1, nb = r & 3;
          tr_item((mat ? p.wk : p.wq) + hh * 16384, 128, 32 * nb, 0, 32, (bf16_t*)(p.ws + WS_MWQ) + mat * 65536 + hh * 16384, 128, 32 * nb, 64 * kb, scr, F.lane, mat ? 0.08838834764831845f : 1.f); }
    }
}
__device__ __forceinline__ void p0_prologue(Frame& F, const P& p) {
    float* rope = (float*)(p.ws + WS_ROPE);
    if (F.vcu == F.G - 1) {
        for (int i = F.tid; i < 1024; i += NWAVES * 64) { const int pos = i >> 4, f = i & 15; const float inv = __builtin_amdgcn_exp2f(-(float)f * (13.287712379549449f / 16.0f));
            const float rev = (float)pos * inv * 0.15915494309189535f; rope[i] = __builtin_amdgcn_cosf(rev); rope[1024 + i] = __builtin_amdgcn_sinf(rev); }
        if (F.wave == 0) { const float s1 = wave_sum(p.lq1[F.lane] * p.lk1[F.lane]), s2 = wave_sum(p.lq2[F.lane] * p.lk2[F.lane]);
            float gq = fabsf(p.q_g[F.lane]), gk = fabsf(p.k_g[F.lane]);
#pragma unroll
            for (int o = 1; o < 64; o <<= 1) { gq = fmaxf(gq, __shfl_xor(gq, o)); gk = fmaxf(gk, __shfl_xor(gk, o)); }
            if (F.lane == 0) { rope[2048] = expf(s1) - expf(s2) + LAM_INIT; rope[2049] = fminf(C2 * 64.f * gq * gk, 60.f); } }
    }
    for (int grp = F.vcu; grp < 96; grp += F.G) {
        LAS float* sc = (LAS float*)(F.lds + RING_OFF);
        LAS float* red = sc + 17 * 1024;
        __syncthreads();
        for (int i = F.tid; i < 17 * 1024; i += NWAVES * 64) { const int b = i >> 10, k = i & 1023; const float v = b < 16 ? p.c[b * 1024 + k] : p.c_ctx[k]; sc[i] = v * ep::fsig(v); }
        __syncthreads();
        const int cl = F.lane & 31, col = grp * 32 + cl, k0 = F.wave * 128 + (F.lane >> 5) * 64;
        float acc[17];
#pragma unroll
        for (int b = 0; b < 17; ++b) acc[b] = 0.f;
#pragma unroll 32
        for (int k = k0; k < k0 + 64; ++k) { const float w = __builtin_nontemporal_load(p.w_mod + (size_t)k * 3072 + col);
#pragma unroll
            for (int b = 0; b < 17; ++b) acc[b] += sc[b * 1024 + k] * w; }
#pragma unroll
        for (int b = 0; b < 17; ++b) { acc[b] += __shfl_xor(acc[b], 32); if (F.lane < 32) red[(F.wave * 17 + b) * 32 + cl] = acc[b]; }
        __syncthreads();
        float* mod = (float*)(p.ws + WS_MOD);
        for (int i = F.tid; i < 17 * 32; i += NWAVES * 64) { const int b = i >> 5, cc = i & 31; float s = p.b_mod[grp * 32 + cc];
#pragma unroll
            for (int w = 0; w < 8; ++w) s += red[(w * 17 + b) * 32 + cc];
            mod[b * 3072 + grp * 32 + cc] = s; }
    }
    __syncthreads();
}
__device__ __forceinline__ void p1_hrows(Frame& F, const P& p) {
    const int gw = F.vcu * NWAVES + F.wave, NGW = F.G * NWAVES;
    LAS float* wg = (LAS float*)(F.lds + RING_OFF);
    __syncthreads();
    for (int kk = F.tid; kk < 1024; kk += NWAVES * 64) { const f32x4* src = (const f32x4*)(p.w_in + (size_t)kk * INW + 4096);
#pragma unroll
        for (int q = 0; q < 4; ++q) { const f32x4 v = src[q]; wg[(4 * q) * 1024 + kk] = v.x; wg[(4 * q + 1) * 1024 + kk] = v.y; wg[(4 * q + 2) * 1024 + kk] = v.z; wg[(4 * q + 3) * 1024 + kk] = v.w; } }
    __syncthreads();
    const float* mod = (const float*)(p.ws + WS_MOD); bf16_t* H = (bf16_t*)(p.ws + WS_H);
    f32x4 nw[4];
#pragma unroll
    for (int j = 0; j < 4; ++j) nw[j] = ((const f32x4*)p.norm_w)[F.lane + 64 * j];
    for (int row = gw; row < RC; row += NGW) {
        const float* xr; int b;
        if (row < R) { xr = p.x + (size_t)row * 1024; b = row >> 11; } else { xr = p.ctx + (size_t)(row - R) * 1024; b = 16; }
        const f32x4* xv = (const f32x4*)xr + F.lane; const f32x4* sh = (const f32x4*)(mod + b * 3072) + F.lane; const f32x4* sc = (const f32x4*)(mod + b * 3072 + 1024) + F.lane;
        f32x4 v[4]; float s = 0.f;
#pragma unroll
        for (int j = 0; j < 4; ++j) { v[j] = __builtin_nontemporal_load(xv + 64 * j); s += (v[j].x * v[j].x + v[j].y * v[j].y) + (v[j].z * v[j].z + v[j].w * v[j].w); }
        const float rn = rsqrtf(wave_sum(s) * (1.f / 1024.f) + EPS);
        unsigned long long* o8 = (unsigned long long*)(H + (size_t)row * 1024) + F.lane;
        f32x4 y[4];
#pragma unroll
        for (int j = 0; j < 4; ++j) { y[j] = v[j] * rn * nw[j] * (sc[64 * j] + 1.f) + sh[64 * j];
            o8[64 * j] = (unsigned long long)pg8::cvt_pk_bf16(y[j].x, y[j].y) | ((unsigned long long)pg8::cvt_pk_bf16(y[j].z, y[j].w) << 32); }
        if (row >= R) {
            float mine = 0.f;
#pragma unroll
            for (int g = 0; g < 16; ++g) { float s = 0.f;
#pragma unroll
                for (int j = 0; j < 4; ++j) { const f32x4 w = *(const LAS f32x4*)(wg + g * 1024 + 4 * F.lane + 256 * j); s += (y[j].x * w.x + y[j].y * w.y) + (y[j].z * w.z + y[j].w * w.w); }
                s = wave_sum(s); if (F.lane == g) mine = s; }
            if (F.lane < 16) { float s = mine + p.b_if[F.lane]; if ((F.lane >> 2) & 1) s = fminf(s, 0.f) - log1pf(expf(-fabsf(s)));
                ((float*)(p.ws + WS_GATES))[(size_t)row * 16 + F.lane] = s; }
        }
    }
    __syncthreads();
}


namespace att {
using bf16x8 = __attribute__((ext_vector_type(8))) short;
using s16x4 = __attribute__((ext_vector_type(4))) short;
using f32x16 = __attribute__((ext_vector_type(16))) float;
using u32x4 = __attribute__((ext_vector_type(4))) unsigned;
typedef short v4i16_t __attribute__((ext_vector_type(4)));
typedef float f32x2_t __attribute__((ext_vector_type(2))); typedef __bf16 bf16x2_t __attribute__((ext_vector_type(2)));
constexpr int SLOT = 16384, LDS_K = 0, LDS_V = 3 * SLOT, LDS_WS = 6 * SLOT, NT = NKEY / 64, STLD = 132;
__device__ __forceinline__ int crow(int r, int hi) { return (r & 3) + 8 * (r >> 2) + 4 * hi; }
__device__ __forceinline__ void glds16(const void* gsrc, unsigned lds_dst) { unsigned keep;
    asm volatile("s_mov_b32 %0, m0\n\ts_mov_b32 m0, %2\n\ts_nop 0\n\tglobal_load_lds_dwordx4 %1, off\n\ts_mov_b32 m0, %0" : "=&s"(keep) : "v"(gsrc), "s"(lds_dst) : "memory"); }
__device__ __forceinline__ unsigned cvtpk_s(float lo, float hi) { f32x2_t v = {lo, hi}; bf16x2_t b = __builtin_convertvector(v, bf16x2_t); return __builtin_bit_cast(unsigned, b); }
typedef LAS const char* lds_cptr;
__device__ __forceinline__ s16x4 vtr(lds_cptr p) { return __builtin_bit_cast(s16x4, __builtin_amdgcn_ds_read_tr16_b64_v4i16((LAS v4i16_t*)p)); }
#define ATT_WAIT_BAR(N) asm volatile("s_waitcnt vmcnt(" #N ") lgkmcnt(0)\n\ts_barrier" ::: "memory")
#define ATT_MFMA(a, b, c) __builtin_amdgcn_mfma_f32_32x32x16_bf16(a, b, c, 0, 0, 0)

__device__ __forceinline__ void attn_unit(int b, int h, int qb, const P& p, LAS unsigned char* shm, float lam, float Mref, bool dry) {
    const int tid = threadIdx.x, lane = tid & 63, r32 = lane & 31, hi = lane >> 5; const int wid = __builtin_amdgcn_readfirstlane(tid >> 6);
    const int map = wid >> 2, qsub = wid & 3;
    bf16_t* Qb = (bf16_t*)(p.ws + WS_Q); const bf16_t* Kb = (const bf16_t*)(p.ws + WS_K); const bf16_t* Vb = (const bf16_t*)(p.ws + WS_V);
    const size_t qrow0 = (size_t)b * SEQ + qb * 128;
    bf16x8 qr[4];
    { const bf16_t* Qw = Qb + (qrow0 + qsub * 32 + r32) * 512 + h * 128 + map * 64 + hi * 8;
#pragma unroll
      for (int d0 = 0; d0 < 4; ++d0) qr[d0] = *(const bf16x8*)(Qw + d0 * 16); }
    const unsigned lds0 = (unsigned)(uintptr_t)shm;
    const bf16_t* ksrc = Kb + (size_t)lane * 512 + h * 128 + wid * 8;
    const bf16_t* vsrc = Vb + (size_t)(16 * (wid & 3) + (lane >> 2)) * 512 + h * 128 + (wid >> 2) * 32 + (lane & 3) * 8;
    const unsigned kdst = lds0 + LDS_K + wid * 1024, vdst = lds0 + LDS_V + (wid >> 2) * 4096 + (wid & 3) * 1024;
#define ATT_TROW(t) ((t) < 4 ? (size_t)R + (size_t)b * CTX + (size_t)(t) * 64 : (size_t)b * SEQ + (size_t)((t) - 4) * 64)
#define ATT_DMA(t, slot) do { const size_t ro_ = ATT_TROW(t) * 512; \
        glds16(ksrc + ro_, (unsigned)__builtin_amdgcn_readfirstlane(kdst + (slot))); glds16(ksrc + ro_ + 64, (unsigned)__builtin_amdgcn_readfirstlane(kdst + (slot) + 8192)); \
        glds16(vsrc + ro_, (unsigned)__builtin_amdgcn_readfirstlane(vdst + (slot))); glds16(vsrc + ro_ + 64, (unsigned)__builtin_amdgcn_readfirstlane(vdst + (slot) + 8192)); } while (0)
    ATT_DMA(0, 0); ATT_DMA(1, SLOT);
    const lds_cptr shm3 = (lds_cptr)shm;
    const lds_cptr kp0 = shm3 + LDS_K + map * 8192 + hi * 1024 + r32 * 16;
    const lds_cptr vp0 = shm3 + LDS_V + ((lane >> 4) & 1) * 32 + (lane & 3) * 8 + (4 * hi + ((lane & 15) >> 2)) * 64;
    f32x16 o[4]; o[0] = f32x16{}; o[1] = f32x16{}; o[2] = f32x16{}; o[3] = f32x16{};
    f32x16 negm;
#pragma unroll
    for (int r = 0; r < 16; ++r) negm[r] = -Mref;
    float l_reg = 0.f;
    ATT_WAIT_BAR(4);
    int sl_cur = 0, sl_n2 = 2 * SLOT;
    for (int t = 0; t < NT; ++t) {
        if (t + 2 < NT) ATT_DMA(t + 2, sl_n2);
        const lds_cptr kp = kp0 + sl_cur, vp = vp0 + sl_cur;
        f32x16 p0, p1;
#pragma unroll
        for (int d0 = 0; d0 < 4; ++d0) {
            const bf16x8 b0 = *(const LAS bf16x8*)(kp + d0 * 2048), b1 = *(const LAS bf16x8*)(kp + d0 * 2048 + 512);
            if (d0 == 0) { p0 = ATT_MFMA(b0, qr[0], negm); p1 = ATT_MFMA(b1, qr[0], negm); }
            else { p0 = ATT_MFMA(b0, qr[d0], p0); p1 = ATT_MFMA(b1, qr[d0], p1); }
        }
        float sacc = 0.f;
#pragma unroll
        for (int r = 0; r < 16; ++r) { p0[r] = __builtin_amdgcn_exp2f(p0[r]); p1[r] = __builtin_amdgcn_exp2f(p1[r]); sacc += p0[r] + p1[r]; }
        l_reg += sacc;
        u32x4 pw[4];
#pragma unroll
        for (int k = 0; k < 4; ++k) { pw[0][k] = cvtpk_s(p0[2 * k], p0[2 * k + 1]); pw[1][k] = cvtpk_s(p0[8 + 2 * k], p0[9 + 2 * k]); pw[2][k] = cvtpk_s(p1[2 * k], p1[2 * k + 1]); pw[3][k] = cvtpk_s(p1[8 + 2 * k], p1[9 + 2 * k]); }
#pragma unroll
        for (int d0 = 0; d0 < 4; ++d0)
#pragma unroll
            for (int ks = 0; ks < 4; ++ks) {
                const s16x4 lo = vtr(vp + d0 * 4096 + ks * 1024), hh = vtr(vp + d0 * 4096 + ks * 1024 + 512);
                const bf16x8 vf = (bf16x8){lo[0], lo[1], lo[2], lo[3], hh[0], hh[1], hh[2], hh[3]};
                o[d0] = ATT_MFMA(__builtin_bit_cast(bf16x8, pw[ks]), vf, o[d0]);
            }
        if (t + 2 < NT) { ATT_WAIT_BAR(4); } else { ATT_WAIT_BAR(0); }
        sl_n2 = sl_cur; sl_cur = (sl_cur == 2 * SLOT) ? 0 : sl_cur + SLOT;
    }
    const size_t go = (qrow0 + (tid >> 2)) * 512 + h * 128 + (tid & 3) * 32;
    u32x4 zwv[4];
    { const bf16_t* za = (const bf16_t*)(p.ws + WS_ZA) + go;
#pragma unroll
      for (int i = 0; i < 4; ++i) zwv[i] = *(const u32x4*)(za + 8 * i); }
    LAS float* wsf = (LAS float*)(shm + LDS_WS) + wid * 64;
    { auto rr = __builtin_amdgcn_permlane32_swap(__float_as_uint(l_reg), __float_as_uint(l_reg), false, false); l_reg = __uint_as_float(rr[0]) + __uint_as_float(rr[1]); }
    if (hi == 0) wsf[r32] = l_reg;
    asm volatile("s_waitcnt lgkmcnt(0)" ::: "memory");
    float scl[16];
#pragma unroll
    for (int r = 0; r < 16; ++r) scl[r] = __builtin_amdgcn_rcpf(wsf[crow(r, hi)]) * (map ? lam : 1.f);
    LAS float* stage = (LAS float*)shm;
    const int qloc = qsub * 32;
    if (map == 1) {
#pragma unroll
        for (int d0 = 0; d0 < 4; ++d0)
#pragma unroll
            for (int r = 0; r < 16; ++r) stage[(qloc + crow(r, hi)) * STLD + 32 * d0 + r32] = o[d0][r] * scl[r];
    }
    asm volatile("s_waitcnt lgkmcnt(0)\n\ts_barrier" ::: "memory");
    if (map == 0) {
#pragma unroll
        for (int d0 = 0; d0 < 4; ++d0)
#pragma unroll
            for (int r = 0; r < 16; ++r) { LAS float* sp = stage + (qloc + crow(r, hi)) * STLD + 32 * d0 + r32; *sp = o[d0][r] * scl[r] - *sp; }
    }
    asm volatile("s_waitcnt lgkmcnt(0)\n\ts_barrier" ::: "memory");
    {
        const int row = tid >> 2, qu = tid & 3;
        const LAS float* sp = stage + row * STLD + qu * 32;
        f32x4 v[8]; float ss = 0.f;
#pragma unroll
        for (int i = 0; i < 8; ++i) { v[i] = *(const LAS f32x4*)(sp + 4 * i); ss += (v[i].x * v[i].x + v[i].y * v[i].y) + (v[i].z * v[i].z + v[i].w * v[i].w); }
        ss += __shfl_xor(ss, 1); ss += __shfl_xor(ss, 2);
        const float rn = rsqrtf(ss * (1.f / 128.f) + EPS) * (1.f - LAM_INIT);
        const float* hg = p.head_g + qu * 32;
#pragma unroll
        for (int i = 0; i < 4; ++i) { const u32x4 zw = zwv[i]; const f32x4 g0 = *(const f32x4*)(hg + 8 * i), g1 = *(const f32x4*)(hg + 8 * i + 4);
            const f32x4 z0 = {ep::lo16(zw.x), ep::hi16(zw.x), ep::lo16(zw.y), ep::hi16(zw.y)}, z1 = {ep::lo16(zw.z), ep::hi16(zw.z), ep::lo16(zw.w), ep::hi16(zw.w)};
            if (!dry) *(u32x4*)(Qb + go + 8 * i) = ep::pack8(v[2 * i] * rn * g0 * z0, v[2 * i + 1] * rn * g1 * z1); }
    }
    asm volatile("s_waitcnt lgkmcnt(0)\n\ts_barrier" ::: "memory");
#undef ATT_DMA
#undef ATT_TROW
}
__device__ __forceinline__ void attn_phase(Frame& F, const P& p, bool dry) {
    const float* sc = (const float*)(p.ws + WS_ROPE) + 2048;
    const float lam = sc[0], Mref = sc[1];
    const int per = (1024 + F.G - 1) / F.G;
    if (F.G == 256) {
        for (int i = 0; i < 4; ++i) { const int bh = (F.vcu >> 4) + 16 * i; attn_unit(bh >> 2, bh & 3, F.vcu & 15, p, F.lds + RING_OFF, lam, Mref, dry); }
    } else
    for (int i = 0; i < per; ++i) { const int u = F.vcu * per + i; if (u < 1024) attn_unit(u >> 6, (u >> 4) & 3, u & 15, p, F.lds + RING_OFF, lam, Mref, dry); }
}
}

namespace ml {
__device__ __forceinline__ void f8(const u32x4_t w, float* o) { o[0] = ep::lo16(w.x); o[1] = ep::hi16(w.x); o[2] = ep::lo16(w.y); o[3] = ep::hi16(w.y); o[4] = ep::lo16(w.z); o[5] = ep::hi16(w.z); o[6] = ep::lo16(w.w); o[7] = ep::hi16(w.w); }
__device__ __forceinline__ void finish_phase(Frame& F, const P& p) {
    const int gw = F.vcu * NWAVES + F.wave, NGW = F.G * NWAVES; const int c0 = F.lane * 8;
    float cw0[8], cw1[8], cw2[8], cbv[8], hg[8], sk[8];
#pragma unroll
    for (int i = 0; i < 8; ++i) { cw0[i] = p.conv_w[c0 + i]; cw1[i] = p.conv_w[512 + c0 + i]; cw2[i] = p.conv_w[1024 + c0 + i]; cbv[i] = p.conv_b[c0 + i]; hg[i] = p.ml_head_g[c0 + i]; sk[i] = p.ml_skip[c0 + i]; }
    const bf16_t* HF = (const bf16_t*)(p.ws + WS_HF); const bf16_t* HB = (const bf16_t*)(p.ws + WS_HB); const bf16_t* XM = (const bf16_t*)(p.ws + WS_XM);
    const bf16_t* OB = (const bf16_t*)(p.ws + WS_OB); const bf16_t* ZB = (const bf16_t*)(p.ws + WS_ZB); bf16_t* YB = (bf16_t*)(p.ws + WS_YB);
    for (int row = gw; row < R; row += NGW) {
        const size_t o = (size_t)row * 512 + c0; const int t = row & (SEQ - 1);
        float hf[8], hb[8], x0[8], x1[8], x2[8], ob[8], zb[8];
        f8(*(const u32x4_t*)(HF + o), hf); f8(*(const u32x4_t*)(HB + o), hb); f8(*(const u32x4_t*)(XM + o), x1);
        f8(*(const u32x4_t*)(OB + o), ob); f8(*(const u32x4_t*)(ZB + o), zb);
        if (t > 0) f8(*(const u32x4_t*)(XM + o - 512), x0); else {
#pragma unroll
            for (int i = 0; i < 8; ++i) x0[i] = 0.f; }
        if (t < SEQ - 1) f8(*(const u32x4_t*)(XM + o + 512), x2); else {
#pragma unroll
            for (int i = 0; i < 8; ++i) x2[i] = 0.f; }
        float ss = 0.f;
#pragma unroll
        for (int i = 0; i < 8; ++i) { hf[i] += hb[i]; ss += hf[i] * hf[i]; }
        ss += __shfl_xor(ss, 1); ss += __shfl_xor(ss, 2); ss += __shfl_xor(ss, 4); ss += __shfl_xor(ss, 8);
        const float rn = rsqrtf(ss * (1.f / 128.f) + EPS);
        float y[8];
#pragma unroll
        for (int i = 0; i < 8; ++i) { const float a = cbv[i] + cw0[i] * x0[i] + cw1[i] * x1[i] + cw2[i] * x2[i]; const float xcv = a * ep::fsig(a);
            y[i] = (ob[i] * (hf[i] * rn * hg[i]) + sk[i] * xcv) * zb[i]; }
        u32x4_t w; w.x = pg8::cvt_pk_bf16(y[0], y[1]); w.y = pg8::cvt_pk_bf16(y[2], y[3]); w.z = pg8::cvt_pk_bf16(y[4], y[5]); w.w = pg8::cvt_pk_bf16(y[6], y[7]);
        *(u32x4_t*)(YB + o) = w;
    }
}
}

namespace mlf {
using bf16x8 = __attribute__((ext_vector_type(8))) short;
using s16x4 = __attribute__((ext_vector_type(4))) short;
using f32x16 = __attribute__((ext_vector_type(16))) float;
typedef short v4i16_t __attribute__((ext_vector_type(4)));
typedef LAS const char* lds_cptr;
typedef unsigned u32x2_t __attribute__((ext_vector_type(2)));
#define MLF_MFMA(a, b, c) __builtin_amdgcn_mfma_f32_32x32x16_bf16(a, b, c, 0, 0, 0)
__device__ __forceinline__ s16x4 vtr(lds_cptr p) { return __builtin_bit_cast(s16x4, __builtin_amdgcn_ds_read_tr16_b64_v4i16((LAS v4i16_t*)p)); }
__device__ __forceinline__ bf16x8 trfrag(lds_cptr p, int second) { const s16x4 lo = vtr(p), hh = vtr(p + second); return (bf16x8){lo[0], lo[1], lo[2], lo[3], hh[0], hh[1], hh[2], hh[3]}; }
__device__ __forceinline__ int crow(int r, int hi) { return (r & 3) + 8 * (r >> 2) + 4 * hi; }

constexpr int PL_WQ = 0, PL_WK = 32768, PL_CV = 65536, PL_XC = 67584;
__device__ __forceinline__ void prep_load_head(const P& p, LAS unsigned char* shm, int h) {
    const int tid = threadIdx.x;
    const bf16_t* WQT = (const bf16_t*)(p.ws + WS_MWQ) + (size_t)h * 16384;
#pragma unroll
    for (int i = 0; i < 8; ++i) { const int idx = tid + 512 * i, mat = idx >> 11, ch = idx & 2047, e = ch >> 4, c = ch & 15;
        *(LAS u32x4_t*)(shm + mat * 32768 + e * 256 + ((c ^ (e & 15)) << 4)) = *(const u32x4_t*)(WQT + mat * 65536 + e * 128 + c * 8); }
    { const int a = tid >> 7, d = tid & 127; ((LAS float*)(shm + PL_CV))[tid] = a < 3 ? p.conv_w[a * 512 + h * 128 + d] : p.conv_b[h * 128 + d]; }
}
struct PrepX { u32x4_t x0[4], x1[4], x2[4]; float mp, mn; };
__device__ __forceinline__ void prep_loadx(const P& p, int c, int h, PrepX& X) {
    const int tid = threadIdx.x, lane = tid & 63, r32 = lane & 31, hi = lane >> 5; const int wid = __builtin_amdgcn_readfirstlane(tid >> 6);
    const int tq = wid & 3, eh = wid >> 2;
    const bool lat = c < 256; const int row0 = lat ? c * 128 : R + (c - 256) * 128;
    const int row = row0 + 32 * tq + r32; const int L = lat ? SEQ : CTX; const int t = (lat ? row : row - R) & (L - 1);
    const char* XM = (const char*)(p.ws + WS_XM) + (unsigned)(row * 1024 + h * 256 + 16 * hi);
    X.mp = t > 0 ? 1.f : 0.f; X.mn = t < L - 1 ? 1.f : 0.f; const int op = t > 0 ? -1024 : 0, on = t < L - 1 ? 1024 : 0;
#pragma unroll
    for (int k4 = 0; k4 < 4; ++k4) { const int ks = 4 * eh + k4; X.x1[k4] = *(const u32x4_t*)(XM + 32 * ks); X.x0[k4] = *(const u32x4_t*)(XM + op + 32 * ks); X.x2[k4] = *(const u32x4_t*)(XM + on + 32 * ks); }
}
__device__ __forceinline__ void prep_unit(const P& p, LAS unsigned char* shm, int c, int h, PrepX& X, int cn, int hn) {
    const int tid = threadIdx.x, lane = tid & 63, r32 = lane & 31, hi = lane >> 5; const int wid = __builtin_amdgcn_readfirstlane(tid >> 6);
    const int tq = wid & 3, eh = wid >> 2;
    const bool lat = c < 256; const int row0 = lat ? c * 128 : R + (c - 256) * 128;
    const int row = row0 + 32 * tq + r32;
    const LAS float* cv = (const LAS float*)(shm + PL_CV) + 8 * hi;
    const lds_cptr wq = (lds_cptr)shm + PL_WQ + (64 * eh + r32) * 256, wk = (lds_cptr)shm + PL_WK + (64 * eh + r32) * 256;
    f32x16 aq[2], ak[2]; aq[0] = f32x16{}; aq[1] = f32x16{}; ak[0] = f32x16{}; ak[1] = f32x16{};
    LAS unsigned char* xcl = shm + PL_XC + tq * 8192 + lane * 16;
#pragma unroll
    for (int k4 = 0; k4 < 4; ++k4) { const int ks = 4 * eh + k4;
        float x0[8], x1[8], x2[8], w0[8], w1[8], w2[8], bb[8];
        ml::f8(X.x0[k4], x0); ml::f8(X.x1[k4], x1); ml::f8(X.x2[k4], x2);
#pragma unroll
        for (int q = 0; q < 2; ++q) { const f32x4 a = *(const LAS f32x4*)(cv + 16 * ks + 4 * q), b = *(const LAS f32x4*)(cv + 128 + 16 * ks + 4 * q), cc = *(const LAS f32x4*)(cv + 256 + 16 * ks + 4 * q), d = *(const LAS f32x4*)(cv + 384 + 16 * ks + 4 * q);
#pragma unroll
            for (int i = 0; i < 4; ++i) { w0[4 * q + i] = a[i]; w1[4 * q + i] = b[i]; w2[4 * q + i] = cc[i]; bb[4 * q + i] = d[i]; } }
        float y[8];
#pragma unroll
        for (int i = 0; i < 8; ++i) { const float a = bb[i] + w0[i] * (x0[i] * X.mp) + w1[i] * x1[i] + w2[i] * (x2[i] * X.mn); y[i] = a * ep::fsig(a); }
        u32x4_t xw; xw.x = pg8::cvt_pk_bf16(y[0], y[1]); xw.y = pg8::cvt_pk_bf16(y[2], y[3]); xw.z = pg8::cvt_pk_bf16(y[4], y[5]); xw.w = pg8::cvt_pk_bf16(y[6], y[7]);
        *(LAS u32x4_t*)(xcl + ks * 1024) = xw;
    }
    asm volatile("s_waitcnt lgkmcnt(0)\n\ts_barrier" ::: "memory");
    if (cn >= 0) prep_loadx(p, cn, hn, X);
#pragma unroll
    for (int ks = 0; ks < 8; ++ks) {
        const bf16x8 xf = *(const LAS bf16x8*)(xcl + ks * 1024);
        const int sw = ((2 * ks + hi) ^ (r32 & 15)) << 4;
#pragma unroll
        for (int nb = 0; nb < 2; ++nb) {
            const bf16x8 wqf = *(const LAS bf16x8*)(wq + nb * 8192 + sw), wkf = *(const LAS bf16x8*)(wk + nb * 8192 + sw);
            aq[nb] = MLF_MFMA(wqf, xf, aq[nb]); ak[nb] = MLF_MFMA(wkf, xf, ak[nb]);
        }
    }
    char* MQ = (char*)(p.ws + WS_MQ) + (unsigned)(row * 1024 + h * 256 + 128 * eh + 8 * hi); char* MK = MQ + (WS_MK - WS_MQ);
#pragma unroll
    for (int nb = 0; nb < 2; ++nb)
#pragma unroll
        for (int g = 0; g < 4; ++g) {
            u32x2_t a, b; a.x = att::cvtpk_s(aq[nb][4 * g], aq[nb][4 * g + 1]); a.y = att::cvtpk_s(aq[nb][4 * g + 2], aq[nb][4 * g + 3]);
            b.x = att::cvtpk_s(ak[nb][4 * g], ak[nb][4 * g + 1]); b.y = att::cvtpk_s(ak[nb][4 * g + 2], ak[nb][4 * g + 3]);
            *(u32x2_t*)(MQ + 64 * nb + 16 * g) = a; *(u32x2_t*)(MK + 64 * nb + 16 * g) = b;
        }
    asm volatile("s_waitcnt lgkmcnt(0)\n\ts_barrier" ::: "memory");
}
__device__ __forceinline__ void prep_phase(Frame& F, const P& p) {
    int hl = -1; PrepX X;
    if (F.vcu < 1152) prep_loadx(p, F.vcu >> 2, F.vcu & 3, X);
    for (int u = F.vcu; u < 1152; u += F.G) { const int h = u & 3;
        if (h != hl) { __syncthreads(); prep_load_head(p, F.lds + RING_OFF, h); __syncthreads(); hl = h; }
        const int un = u + F.G;
        prep_unit(p, F.lds + RING_OFF, u >> 2, h, X, un < 1152 ? (un >> 2) : -1, un & 3); }
    __syncthreads();
}

constexpr int L_KT = 0  , L_VP = 65536, L_CB = 90112, L_GT = 106496  , L_NV = 112128;
constexpr int GT_WROW = 0, GT_MU2 = 512, GT_DEC = 1024, GT_CLAMP = 1536, GT_WGT = 2048, GT_CARRY = 2560, GT_STRIDE = 2816;
constexpr float LOG2E = 1.4426950408889634f;
__device__ __forceinline__ void glds16(const void* gsrc, unsigned lds_dst) { unsigned keep;
    asm volatile("s_mov_b32 %0, m0\n\ts_mov_b32 m0, %2\n\ts_nop 0\n\tglobal_load_lds_dwordx4 %1, off\n\ts_mov_b32 m0, %0" : "=&s"(keep) : "v"(gsrc), "s"(lds_dst) : "memory"); }
#define MLF_GL16(dst, ptr) asm volatile("global_load_dwordx4 %0, %1, off" : "=v"(dst) : "v"(ptr) : "memory")

#ifndef TPROBE
#define TPROBE 0
#endif
#define TP_ON(k) if (TPROBE == (k)) tp_t0 = __builtin_amdgcn_s_memrealtime()
#define TP_OFF(k) if (TPROBE == (k)) tp_acc += __builtin_amdgcn_s_memrealtime() - tp_t0
template <bool NOMEM> __device__ __forceinline__ void chain_unit(const P& p, LAS unsigned char* shm, int u) {
    unsigned long long tp_t0 = 0, tp_acc = 0; TP_ON(1);
    const int tid = threadIdx.x, lane = tid & 63, r32 = lane & 31, hi = lane >> 5; const int wid = __builtin_amdgcn_readfirstlane(tid >> 6);
    const int vh = u & 1, dir = (u >> 1) & 1, h = (u >> 2) & 3, b = u >> 4;
    const bf16_t* MQ = (const bf16_t*)(p.ws + WS_MQ) + h * 128; const bf16_t* MK = (const bf16_t*)(p.ws + WS_MK) + h * 128; const bf16_t* VM = (const bf16_t*)(p.ws + WS_VM) + h * 128 + 64 * vh;
    const float* GG = (const float*)(p.ws + WS_GATES) + dir * 8 + h;
    bf16_t* HO = (bf16_t*)(p.ws + (dir ? WS_HB : WS_HF)) + h * 128 + 64 * vh;
    const unsigned lds0 = (unsigned)(uintptr_t)shm; const lds_cptr shm3 = (lds_cptr)shm;
    const int trofs = ((lane >> 4) & 1) * 32 + (lane & 3) * 8;
    const int tr_perm = trofs + (4 * hi + ((lane & 15) >> 2)) * 64;
    const int tr_nat = trofs + (8 * hi + ((lane & 15) >> 2)) * 64;
    const int krow = (r32 >> 4) * 1024 + (r32 & 15) * 64 + 16 * hi;
    const int sgn = dir ? -1 : 1;
#define MLF_RSTART(j) ((j) < 2 ? R + b * CTX + (dir ? (CTX - 1 - 128 * (j)) : (128 * (j))) : b * SEQ + (dir ? (SEQ - 1 - 128 * ((j) - 2)) : (128 * ((j) - 2))))
#define MLF_AT(base, rowi, colb) ((const char*)(base) + (unsigned)((rowi) * 1024 + (colb)))
#define MLF_DMA_K(j) do { if (NOMEM) break; const int rs_ = MLF_RSTART(j); \
        _Pragma("unroll") for (int i_ = 0; i_ < 4; ++i_) { const int pc_ = 4 * wid + i_, eb_ = pc_ >> 3, sg_ = pc_ & 7; \
            glds16(MLF_AT(MK, rs_ + sgn * (16 * sg_ + (lane >> 2)), 64 * eb_ + (lane & 3) * 16), (unsigned)__builtin_amdgcn_readfirstlane(lds0 + L_KT + ((j) & 1) * 32768 + pc_ * 1024)); } } while (0)
#define MLF_GLOAD(j) do { if (NOMEM) break; const int rs_ = MLF_RSTART(j); \
        const float* g0_ = (const float*)((const char*)GG + (unsigned)((rs_ + sgn * (2 * lane)) * 64)); const float* g1_ = (const float*)((const char*)GG + (unsigned)((rs_ + sgn * (2 * lane + 1)) * 64)); \
        graw[0] = g0_[0]; graw[1] = g0_[4]; graw[2] = g1_[0]; graw[3] = g1_[4]; } while (0)
#define MLF_GATES(j) do { LAS float* gt_ = (LAS float*)(shm + L_GT + ((j) & 1) * GT_STRIDE); \
        const float i0_ = graw[0], f0_ = graw[1], i1_ = graw[2], f1_ = graw[3]; \
        float cs_ = f0_ + f1_; _Pragma("unroll") for (int o_ = 1; o_ < 64; o_ <<= 1) { const float t_ = __shfl_up(cs_, o_); if (lane >= o_) cs_ += t_; } \
        const float c1_ = cs_, c0_ = cs_ - f1_; const float a0_ = i0_ - c0_, a1_ = i1_ - c1_; \
        float mx_ = fmaxf(a0_, a1_); _Pragma("unroll") for (int o_ = 1; o_ < 64; o_ <<= 1) { const float t_ = __shfl_up(mx_, o_); if (lane >= o_) mx_ = fmaxf(mx_, t_); } \
        float pm_ = __shfl_up(mx_, 1); if (lane == 0) pm_ = -3.0e38f; \
        const float mu0_ = fmaxf(mst, fmaxf(pm_, a0_)), mu1_ = fmaxf(mst, mx_); \
        const float muend_ = __shfl(mu1_, 63), ftot_ = __shfl(c1_, 63); \
        typedef float f2_ __attribute__((ext_vector_type(2))); \
        ((LAS f2_*)(gt_ + GT_WROW / 4))[lane] = (f2_){__expf(muend_ - mu0_), __expf(muend_ - mu1_)}; \
        ((LAS f2_*)(gt_ + GT_DEC / 4))[lane] = (f2_){__expf(mst - mu0_), __expf(mst - mu1_)}; ((LAS f2_*)(gt_ + GT_CLAMP / 4))[lane] = (f2_){__expf(-(c0_ + mu0_)), __expf(-(c1_ + mu1_))}; \
        ((LAS f2_*)(gt_ + GT_WGT / 4))[lane] = (f2_){__expf(a0_ - muend_), __expf(a1_ - muend_)}; if (lane == 0) gt_[GT_CARRY / 4] = __expf(mst - muend_); \
        mst = ftot_ + muend_; } while (0)
    float mst = 0.f;
    __syncthreads();
    for (int i = tid; i < 16384 / 16; i += 512) *(LAS u32x4_t*)(shm + L_CB + i * 16) = (u32x4_t){0u, 0u, 0u, 0u};
    for (int i = tid; i < 8192 / 16; i += 512) *(LAS u32x4_t*)(shm + L_VP + 16384 + i * 16) = (u32x4_t){0u, 0u, 0u, 0u};
    if (tid < 128) ((LAS float*)(shm + L_NV))[tid] = 0.f;
    float graw[4] = {0.f, 0.f, 0.f, 0.f};
    if (wid == 0) { MLF_GLOAD(0); MLF_GATES(0); MLF_GLOAD(1); }
    MLF_DMA_K(0); MLF_DMA_K(1);
#define MLF_BAR_A() asm volatile("s_waitcnt lgkmcnt(0)\n\ts_barrier" ::: "memory")
#define MLF_BAR_B(N) asm volatile("s_waitcnt vmcnt(" #N ") lgkmcnt(0)\n\ts_barrier" ::: "memory")
    MLF_BAR_B(0);
    if (wid < 4) {
        const int tq = wid;
        f32x16 S[4]; S[0] = f32x16{}; S[1] = f32x16{}; S[2] = f32x16{}; S[3] = f32x16{};
#define PWSET(st, kk, k, val) S[2 + ((st) >> 1)][((st) & 1) * 8 + (kk) * 4 + (k)] = __uint_as_float(val)
#define PWGET(st, kk) __builtin_bit_cast(bf16x8, (f32x4){S[2 + ((st) >> 1)][((st) & 1) * 8 + (kk) * 4], S[2 + ((st) >> 1)][((st) & 1) * 8 + (kk) * 4 + 1], S[2 + ((st) >> 1)][((st) & 1) * 8 + (kk) * 4 + 2], S[2 + ((st) >> 1)][((st) & 1) * 8 + (kk) * 4 + 3]})
        u32x4_t qf[8];
#pragma unroll
        for (int ks = 0; ks < 8; ++ks) qf[ks] = (u32x4_t){0u, 0u, 0u, 0u};
        for (int j = 0; j < 18; ++j) {
            int rs = MLF_RSTART(j); asm volatile("" : "+s"(rs));
            const LAS float* gt = (const LAS float*)(shm + L_GT + (j & 1) * GT_STRIDE);
            float dq = 0.f;
            TP_ON(2);
            if (j >= 2) {
                const float wrow = gt[GT_WROW / 4 + 32 * tq + r32];
                const lds_cptr kt = shm3 + L_KT + (j & 1) * 32768 + krow;
                const lds_cptr cb = shm3 + L_CB + tr_nat;
                s16x4 tc0[16], tc1[16];
#pragma unroll
                for (int ks = 0; ks < 8; ++ks) { tc0[2 * ks] = vtr(cb + ks * 1024); tc0[2 * ks + 1] = vtr(cb + ks * 1024 + 256); }
                bf16x8 kf[8];
#pragma unroll
                for (int ks = 0; ks < 8; ++ks) kf[ks] = *(const LAS bf16x8*)(kt + (ks >> 1) * 8192 + (ks & 1) * 32);
                __builtin_amdgcn_sched_barrier(0);
#pragma unroll
                for (int st = 0; st < 4; ++st) if (st <= tq) {
                    f32x16 X = f32x16{};
#pragma unroll
                    for (int ks = 0; ks < 8; ++ks) X = MLF_MFMA(kf[ks], __builtin_bit_cast(bf16x8, qf[ks]), X);
                    if (st < tq) {
#pragma unroll
                        for (int ks = 0; ks < 8; ++ks) kf[ks] = *(const LAS bf16x8*)(kt + (st + 1) * 2048 + (ks >> 1) * 8192 + (ks & 1) * 32); }
                    X = X * wrow;
                    if (st == tq) {
#pragma unroll
                        for (int r = 0; r < 16; ++r) if (crow(r, hi) > r32) X[r] = 0.f; }
#pragma unroll
                    for (int k = 0; k < 4; ++k) { PWSET(st, 0, k, att::cvtpk_s(X[2 * k], X[2 * k + 1])); PWSET(st, 1, k, att::cvtpk_s(X[8 + 2 * k], X[9 + 2 * k])); }
                }
                const float decs = gt[GT_DEC / 4 + 32 * tq + r32];
#pragma unroll
                for (int ks = 0; ks < 8; ++ks) { tc1[2 * ks] = vtr(cb + 8192 + ks * 1024); tc1[2 * ks + 1] = vtr(cb + 8192 + ks * 1024 + 256); }
                __builtin_amdgcn_sched_barrier(0);
                { f32x16 a = f32x16{};
#pragma unroll
                  for (int ks = 0; ks < 8; ++ks) { const s16x4 lo = tc0[2 * ks], hh = tc0[2 * ks + 1]; a = MLF_MFMA(((bf16x8){lo[0], lo[1], lo[2], lo[3], hh[0], hh[1], hh[2], hh[3]}), __builtin_bit_cast(bf16x8, qf[ks]), a); }
                  S[0] = a * decs; }
                { f32x16 a = f32x16{};
#pragma unroll
                  for (int ks = 0; ks < 8; ++ks) { const s16x4 lo = tc1[2 * ks], hh = tc1[2 * ks + 1]; a = MLF_MFMA(((bf16x8){lo[0], lo[1], lo[2], lo[3], hh[0], hh[1], hh[2], hh[3]}), __builtin_bit_cast(bf16x8, qf[ks]), a); }
                  S[1] = a * decs; }
                const LAS float* nv = (const LAS float*)(shm + L_NV);
                float qn = 0.f;
#pragma unroll
                for (int ks = 0; ks < 8; ++ks) { float qv[8]; ml::f8(qf[ks], qv); const f32x4 n0 = *(const LAS f32x4*)(nv + 16 * ks + 8 * hi), n1 = *(const LAS f32x4*)(nv + 16 * ks + 8 * hi + 4);
                    qn += (qv[0] * n0[0] + qv[1] * n0[1]) + (qv[2] * n0[2] + qv[3] * n0[3]) + (qv[4] * n1[0] + qv[5] * n1[1]) + (qv[6] * n1[2] + qv[7] * n1[3]); }
                { auto rr = __builtin_amdgcn_permlane32_swap(__float_as_uint(qn), __float_as_uint(qn), false, false); qn = __uint_as_float(rr[0]) + __uint_as_float(rr[1]); }
                dq = decs * qn;
            }
            if (wid == 0 && j + 1 < 18) MLF_GATES(j + 1);
            TP_OFF(2); TP_ON(3);
            MLF_BAR_A();
            TP_OFF(3); TP_ON(4);
            if (!NOMEM && j + 1 >= 2 && j + 1 < 18) { const char* qp = MLF_AT(MQ, MLF_RSTART(j + 1) + sgn * (32 * tq + r32), 16 * hi);
#pragma unroll
                for (int ks = 0; ks < 8; ++ks) qf[ks] = *(const u32x4_t*)(qp + 32 * ks); }
            if (wid == 0 && j + 2 < 18) MLF_GLOAD(j + 2);
            if (j >= 2) {
                const lds_cptr vv = shm3 + L_VP + tr_perm;
                char* hop = (char*)HO + (unsigned)((rs + sgn * (32 * tq + r32)) * 1024 + 8 * hi);
                f32x16 accd = f32x16{};
#pragma unroll
                for (int sp = 0; sp < 2; ++sp) if (2 * sp <= tq) {
                    s16x4 tv[24];
#pragma unroll
                    for (int s2 = 0; s2 < 2; ++s2) if (2 * sp + s2 <= tq)
#pragma unroll
                        for (int kk = 0; kk < 2; ++kk)
#pragma unroll
                            for (int db = 0; db < 3; ++db) { const int sg = 2 * (2 * sp + s2) + kk, i = ((s2 * 2 + kk) * 3 + db) * 2; tv[i] = vtr(vv + db * 8192 + sg * 1024); tv[i + 1] = vtr(vv + db * 8192 + sg * 1024 + 512); }
                    __builtin_amdgcn_sched_barrier(0);
#pragma unroll
                    for (int s2 = 0; s2 < 2; ++s2) if (2 * sp + s2 <= tq)
#pragma unroll
                        for (int kk = 0; kk < 2; ++kk) { const bf16x8 pf = PWGET(2 * sp + s2, kk);
#pragma unroll
                            for (int db = 0; db < 3; ++db) { const int i = ((s2 * 2 + kk) * 3 + db) * 2; const bf16x8 vf8 = (bf16x8){tv[i][0], tv[i][1], tv[i][2], tv[i][3], tv[i + 1][0], tv[i + 1][1], tv[i + 1][2], tv[i + 1][3]};
                                if (db == 2) accd = MLF_MFMA(vf8, pf, accd); else S[db] = MLF_MFMA(vf8, pf, S[db]); } }
                    __builtin_amdgcn_sched_barrier(0);
                }
                float dsum = hi == 0 ? accd[0] : 0.f;
                { auto rr = __builtin_amdgcn_permlane32_swap(__float_as_uint(dsum), __float_as_uint(dsum), false, false); dsum = __uint_as_float(rr[0]) + __uint_as_float(rr[1]); }
                const float hinv = __builtin_amdgcn_rcpf(fmaxf(fabsf(dsum + dq), gt[GT_CLAMP / 4 + 32 * tq + r32]));
#pragma unroll
                for (int db = 0; db < 2; ++db) {
                    const f32x16 acc = S[db] * hinv;
#pragma unroll
                    for (int g = 0; g < 4; ++g) { u32x2_t w; w.x = att::cvtpk_s(acc[4 * g], acc[4 * g + 1]); w.y = att::cvtpk_s(acc[4 * g + 2], acc[4 * g + 3]); if (!NOMEM) *(u32x2_t*)(hop + 64 * db + 16 * g) = w; else asm volatile("" :: "v"(w)); }
                }
            }
            TP_OFF(4); TP_ON(5);
            MLF_BAR_B(8);
            TP_OFF(5);
            if (j + 2 < 18) MLF_DMA_K(j + 2);
        }
    } else {
        const int et = wid - 4;
        f32x16 C[3]; C[0] = f32x16{}; C[1] = f32x16{}; C[2] = f32x16{};
        const int t4 = tid - 256; const int vs = t4 >> 1, vdb = t4 & 1;
        u32x4_t vf[4];
        if (!NOMEM) { const char* vp = MLF_AT(VM, MLF_RSTART(0) + sgn * vs, 64 * vdb);
#pragma unroll
          for (int c = 0; c < 4; ++c) vf[c] = *(const u32x4_t*)(vp + 16 * c); }
        else { vf[0] = vf[1] = vf[2] = vf[3] = (u32x4_t){0u, 0u, 0u, 0u}; }
        for (int j = 0; j < 18; ++j) {
            const LAS float* gt = (const LAS float*)(shm + L_GT + (j & 1) * GT_STRIDE);
            TP_ON(6);
            { const float wg = gt[GT_WGT / 4 + vs];
              LAS unsigned char* dst = shm + L_VP + vdb * 8192 + (vs >> 4) * 1024 + (vs & 15) * 64;
#pragma unroll
              for (int c = 0; c < 4; ++c) { float v[8]; ml::f8(vf[c], v);
                  u32x4_t w; w.x = pg8::cvt_pk_bf16(v[0] * wg, v[1] * wg); w.y = pg8::cvt_pk_bf16(v[2] * wg, v[3] * wg); w.z = pg8::cvt_pk_bf16(v[4] * wg, v[5] * wg); w.w = pg8::cvt_pk_bf16(v[6] * wg, v[7] * wg);
                  *(LAS u32x4_t*)(dst + 16 * c) = w; }
              if (vdb == 0) *(LAS bf16_t*)(shm + L_VP + 16384 + (vs >> 4) * 1024 + (vs & 15) * 64) = f2bf(wg); }
            TP_OFF(6); TP_ON(8);
            MLF_BAR_A();
            TP_OFF(8); TP_ON(7);
            if (!NOMEM && j + 1 < 18) { const char* vp = MLF_AT(VM, MLF_RSTART(j + 1) + sgn * vs, 64 * vdb);
#pragma unroll
                for (int c = 0; c < 4; ++c) vf[c] = *(const u32x4_t*)(vp + 16 * c); }
            const float carry = gt[GT_CARRY / 4];
            const lds_cptr ka = shm3 + L_KT + (j & 1) * 32768 + et * 8192 + tr_perm; const lds_cptr vb = shm3 + L_VP + tr_perm;
#pragma unroll
            for (int db = 0; db < 3; ++db)
#pragma unroll
                for (int r = 0; r < 16; ++r) C[db][r] *= carry;
#pragma unroll
            for (int half = 0; half < 2; ++half) {
                s16x4 ta[8], tb[24];
#pragma unroll
                for (int k4 = 0; k4 < 4; ++k4) { const int ks = 4 * half + k4; ta[2 * k4] = vtr(ka + ks * 1024); ta[2 * k4 + 1] = vtr(ka + ks * 1024 + 512);
#pragma unroll
                    for (int db = 0; db < 3; ++db) { tb[6 * k4 + 2 * db] = vtr(vb + db * 8192 + ks * 1024); tb[6 * k4 + 2 * db + 1] = vtr(vb + db * 8192 + ks * 1024 + 512); } }
                __builtin_amdgcn_sched_barrier(0);
#pragma unroll
                for (int k4 = 0; k4 < 4; ++k4) { const bf16x8 af = (bf16x8){ta[2 * k4][0], ta[2 * k4][1], ta[2 * k4][2], ta[2 * k4][3], ta[2 * k4 + 1][0], ta[2 * k4 + 1][1], ta[2 * k4 + 1][2], ta[2 * k4 + 1][3]};
#pragma unroll
                    for (int db = 0; db < 3; ++db) { const s16x4 lo = tb[6 * k4 + 2 * db], hh = tb[6 * k4 + 2 * db + 1];
                        C[db] = MLF_MFMA(((bf16x8){lo[0], lo[1], lo[2], lo[3], hh[0], hh[1], hh[2], hh[3]}), af, C[db]); } }
                __builtin_amdgcn_sched_barrier(0);
            }
            { const int e = 32 * et + r32; LAS unsigned char* cbn = shm + L_CB + (e >> 4) * 1024 + (e & 15) * 64 + 8 * hi;
#pragma unroll
              for (int db = 0; db < 2; ++db)
#pragma unroll
                  for (int g = 0; g < 4; ++g) { u32x2_t w; w.x = att::cvtpk_s(C[db][4 * g], C[db][4 * g + 1]); w.y = att::cvtpk_s(C[db][4 * g + 2], C[db][4 * g + 3]); *(LAS u32x2_t*)(cbn + db * 8192 + 16 * g) = w; }
              if (hi == 0) ((LAS float*)(shm + L_NV))[e] = C[2][0]; }
            TP_OFF(7); TP_ON(9);
            MLF_BAR_B(4);
            TP_OFF(9);
            if (j + 2 < 18) MLF_DMA_K(j + 2);
        }
    }
    asm volatile("s_waitcnt vmcnt(0) lgkmcnt(0)\n\ts_barrier" ::: "memory");
    TP_OFF(1);
    if (TPROBE) { const unsigned long long s0 = __builtin_amdgcn_s_memrealtime(); while (__builtin_amdgcn_s_memrealtime() - s0 < tp_acc) __builtin_amdgcn_s_sleep(1); asm volatile("s_barrier" ::: "memory"); }
#undef MLF_BAR_A
#undef MLF_BAR_B
#undef PWSET
#undef PWGET
#undef MLF_DMA_K
#undef MLF_AT
#undef MLF_GATES
#undef MLF_GLOAD
#undef MLF_RSTART
}
__device__ __forceinline__ void chain_phase(Frame& F, const P& p) {
#if (PROBE_DUP >> 10) & 1
    for (int u = F.vcu; u < 256; u += F.G) chain_unit<true>(p, F.lds + RING_OFF, u);
#endif
    for (int u = F.vcu; u < 256; u += F.G) chain_unit<false>(p, F.lds + RING_OFF, u); }
}

#ifndef PROBE_DUP
#define PROBE_DUP 0
#endif
__device__ __forceinline__ int reps_of(int k) { int r = ((PROBE_DUP >> k) & 1) ? 2 : 1; if (PROBE_DUP) asm volatile("" : "+s"(r)); return r; }
#define REPS(k) reps_of(k)
struct Args { P p; int ph_lo, ph_hi, li, pad; };
__global__ void __launch_bounds__(NWAVES * 64, 2) skel_fwd(Args args) {
    extern __shared__ __attribute__((aligned(16))) unsigned char lds[];
    Frame F;
    F.lds = (LAS unsigned char*)lds;
    F.MISC = (volatile LAS unsigned*)(F.lds + MISC_OFF);
    F.tid = threadIdx.x; F.lane = F.tid & 63; F.wave = __builtin_amdgcn_readfirstlane(F.tid >> 6);
    F.G = gridDim.x; { const int bx = blockIdx.x; F.vcu = (F.G % 8 == 0) ? (bx % 8) * (F.G / 8) + bx / 8 : bx; }
    const P& p = args.p;
    F.ctl = (gu32*)(p.ws + WS_CTL);
    for (int u = F.tid; u < (LDS_BYTES - LDSCTL_OFF) / 4; u += NWAVES * 64) ((LAS unsigned*)(F.lds + LDSCTL_OFF))[u] = 0u;
    __syncthreads();
    const int lo = args.ph_lo, hi = args.ph_hi;
    XcdBarrier bar = xcd_barrier_post((unsigned*)(F.ctl + CW_BAR) + args.li * XCD_BAR_WORDS, F.MISC + 8);
#define IN(k) (lo <= (k) && (k) < hi)
#define BOTH(k) (IN(k) && (k) + 1 < hi)
#define GRID_BAR() xcd_barrier(bar)
    if (IN(0)) { for (int rep = 0; rep < REPS(0); ++rep) p0_prologue(F, p); if (BOTH(0)) GRID_BAR(); }
    if (IN(1)) { for (int rep = 0; rep < REPS(1); ++rep) { p1_hrows(F, p); p_transposes(F, p); } if (BOTH(1)) GRID_BAR(); }
#if (PROBE_DUP >> 9) & 1
    for (int rep = 0; rep < 16; ++rep) GRID_BAR();
#endif
    if (IN(2)) {
        pg8::Gemm g{(const bf16_t*)(p.ws + WS_H), (const bf16_t*)(p.ws + WS_WTIN), nullptr, nullptr, 1024};
        ep::SchedIn S; S.init(F.G, (int)blockIdx.x);
        ep::EpiIn E{p.ws, p.q_g, p.k_g, p.b_if};
        pg8::gemm_phase<ep::EpiIn, ep::SchedIn, true, true>(F.lds + RING_OFF, g, S, E);
        if (BOTH(2)) GRID_BAR();
    }
    if (IN(3)) { for (int rep = 0; rep < REPS(3); ++rep) att::attn_phase(F, p, rep + 1 < REPS(3)); for (int rep = 0; rep < REPS(8); ++rep) mlf::prep_phase(F, p); if (BOTH(3)) GRID_BAR(); }
    if (IN(4)) { for (int rep = 0; rep < REPS(4); ++rep) mlf::chain_phase(F, p); if (BOTH(4)) GRID_BAR(); }
    if (IN(5)) { for (int rep = 0; rep < REPS(5); ++rep) ml::finish_phase(F, p); if (BOTH(5)) GRID_BAR(); }
    if (IN(6)) {
        pg8::Gemm g{(const bf16_t*)(p.ws + WS_Q), (const bf16_t*)(p.ws + WS_WTOA), (const bf16_t*)(p.ws + WS_YB), (const bf16_t*)(p.ws + WS_WTOB), 512};
        ep::SchedMerge S; S.init(F.G, (int)blockIdx.x);
        ep::EpiMerge E{(bf16_t*)(p.ws + WS_GA), (bf16_t*)(p.ws + WS_GB)};
        pg8::gemm_phase<ep::EpiMerge, ep::SchedMerge, true, true>(F.lds + RING_OFF, g, S, E);
        if (BOTH(6)) GRID_BAR();
    }
    if (IN(7)) {
        pg8::Gemm g{(const bf16_t*)(p.ws + WS_GB), (const bf16_t*)(p.ws + WS_WTO), nullptr, nullptr, 1024};
        ep::SchedOut S; S.init(F.G, (int)blockIdx.x);
        ep::EpiOut E{p.x, (const float*)(p.ws + WS_MOD), p.out};
        pg8::gemm_phase<ep::EpiOut, ep::SchedOut, true, true>(F.lds + RING_OFF, g, S, E);
    }
#undef IN
#undef BOTH
#undef GRID_BAR
}

extern "C" void kernel_launch(void* const* d_in, const int* in_sizes, int n_in, void* d_out, int out_size, void* d_ws, size_t ws_size, hipStream_t stream) {
    static int grid = 0;
    if (grid == 0) {
        if (n_in != 25 || ws_size < WS_END || out_size != R * 1024) { fprintf(stderr, "kernel_launch: bad args n_in %d ws %zu out %d\n", n_in, ws_size, out_size); grid = -1; return; }
        int dev = 0, cus = 0, per_cu = 0;
        if (hipGetDevice(&dev) != hipSuccess || hipDeviceGetAttribute(&cus, hipDeviceAttributeMultiprocessorCount, dev) != hipSuccess) { grid = -1; return; }
        if (hipFuncSetAttribute((const void*)skel_fwd, hipFuncAttributeMaxDynamicSharedMemorySize, LDS_BYTES) != hipSuccess) { fprintf(stderr, "hipFuncSetAttribute failed\n"); grid = -1; return; }
        if (hipOccupancyMaxActiveBlocksPerMultiprocessor(&per_cu, (const void*)skel_fwd, NWAVES * 64, LDS_BYTES) != hipSuccess || per_cu < 1) { fprintf(stderr, "occupancy query: %d blocks per CU\n", per_cu); grid = -1; (void)hipGetLastError(); return; }
        grid = cus;
    }
    if (grid < 0) return;
    if (hipMemsetAsync((char*)d_ws + WS_CTL, 0, CTL_ZERO_BYTES, stream) != hipSuccess) return;
    Args a{};
    const float** pp = (const float**)&a.p;
    for (int i = 0; i < 25; ++i) pp[i] = (const float*)d_in[i];
    a.p.out = (float*)d_out; a.p.ws = (unsigned char*)d_ws;
    const P& p = a.p;
    a.ph_lo = 0; a.ph_hi = 8; a.li = 0;
    hipLaunchKernelGGL(skel_fwd, dim3(grid), dim3(NWAVES * 64), LDS_BYTES, stream, a);
}
```

```cpp
#include <hip/hip_runtime.h>
#include <cstdio>
#include <cstdint>
#include <cmath>

#ifndef PROBE_DUP
#define PROBE_DUP 0
#endif
typedef unsigned short bf16_t;
__device__ __forceinline__ float bf2f(bf16_t v) { return __uint_as_float(((unsigned)v) << 16); }
__device__ __forceinline__ bf16_t f2bf(float f) { unsigned u = __float_as_uint(f); return (bf16_t)((u + 0x7fffu + ((u >> 16) & 1u)) >> 16); }

constexpr int DM = 1024, NB = 16, SEQ = 2048, CTX = 256;
constexpr int R = NB * SEQ;
constexpr int RCX = NB * CTX;
constexpr int RC = R + RCX;
constexpr int INW = 6160;
constexpr int NKEY = CTX + SEQ;
constexpr float EPS = 1e-6f;
constexpr float C2 = 0.125f * 1.4426950408889634f;
constexpr float LAM_INIT = 0.2f;

constexpr size_t MiB = 1u << 20;
constexpr size_t WS_CTL = 0;
constexpr size_t WS_MOD = 1 * MiB;
constexpr size_t WS_ROPE = 1 * MiB + 256 * 1024;
constexpr size_t WS_GATES = 2 * MiB;
constexpr size_t WS_WTIN = 6 * MiB;
constexpr size_t WS_WTOA = 19 * MiB, WS_WTOB = 20 * MiB, WS_WTO = 21 * MiB, WS_MWQ = 23 * MiB;
constexpr size_t WS_H = 24 * MiB;
constexpr size_t WS_MQ = 24 * MiB, WS_MK = 60 * MiB;
constexpr size_t WS_Q = 96 * MiB;
constexpr size_t WS_K = 128 * MiB;
constexpr size_t WS_V = 164 * MiB;
constexpr size_t WS_HF = WS_K, WS_HB = WS_V;
constexpr size_t WS_ZA = 200 * MiB;
constexpr size_t WS_YB = WS_ZA;
constexpr size_t WS_XM = 232 * MiB;
constexpr size_t WS_VM = 268 * MiB;
constexpr size_t WS_ZB = 304 * MiB;
constexpr size_t WS_OB = 336 * MiB;
constexpr size_t WS_GA = 368 * MiB;
constexpr size_t WS_GB = 432 * MiB;
constexpr size_t WS_END = 496 * MiB;

struct P {
    const float *x, *c, *ctx, *c_ctx, *norm_w, *w_mod, *b_mod, *w_in, *b_if, *q_g, *k_g, *lq1, *lk1, *lq2, *lk2, *head_g, *w_out_a,
        *conv_w, *conv_b, *wq, *wk, *ml_head_g, *ml_skip, *w_out_b, *w_o;
    float* out; unsigned char* ws;
};

__device__ __forceinline__ float siluf(float v) { return v / (1.f + expf(-v)); }
__device__ __forceinline__ float sigmf(float v) { return 1.f / (1.f + expf(-v)); }
__device__ __forceinline__ float logsigf(float v) { return fminf(v, 0.f) - log1pf(expf(-fabsf(v))); }
__device__ __forceinline__ int jperm(int dd) { return 8 * ((dd & 15) >> 2) + 4 * (dd >> 4) + (dd & 3); }


namespace pg8 {
#define PG8_LAS __attribute__((address_space(3)))
typedef unsigned short bf16_t;
typedef short bf16x8 __attribute__((ext_vector_type(8)));
typedef float f32x4 __attribute__((ext_vector_type(4)));
typedef unsigned u32x4 __attribute__((ext_vector_type(4)));
constexpr int BM = 256, BK = 64, HALF = 128, HTB = HALF * BK * 2  , STAGE_BYTES = 8 * HTB, NXCD = 8, WGM = 8;

__host__ __device__ __forceinline__ int lds_byte(int r, int c) { const int st = (r >> 4) * 2 + (c >> 5), rr = r & 15, cc = c & 31, ob = rr * 64 + cc * 2; return st * 1024 + (ob ^ (((ob >> 9) & 1) << 5)); }
__host__ __device__ __forceinline__ void stage_rc(int b, int& R, int& C) { const int st = b / 1024, sb = b % 1024, swz = sb ^ (((sb >> 9) & 1) << 5); R = (st >> 1) * 16 + swz / 64; C = (st & 1) * 32 + (swz % 64) / 2; }
__host__ __device__ __forceinline__ int perm32(int rho) { const int n = rho >> 4, i = rho & 15; return 8 * (i >> 2) + 4 * n + (i & 3); }

struct Unit { int pm, pn, sel; };
struct Gemm { const bf16_t* A0; const bf16_t* B0; const bf16_t* A1; const bf16_t* B1; int K; };

struct StaticOrder {
    int nM, nN, nwg, G, c;
    __host__ __device__ void init(int M, int N, int G_, int c_) { nM = M / BM; nN = N / BM; nwg = nM * nN; G = G_; c = c_; }
    __host__ __device__ __forceinline__ bool next(int i, Unit& u) const {
        const long L = (long)i * G + c; const bool ok = L < nwg;
        int wgid = ok ? (int)L : 0; { const int q = nwg / NXCD, r = nwg % NXCD, xcd = wgid % NXCD, off = wgid / NXCD; wgid = (xcd < r ? xcd * (q + 1) : r * (q + 1) + (xcd - r) * q) + off; }
        const int nig = WGM * nN, gid = wgid / nig, fm = gid * WGM, gsz = (nM - fm) < WGM ? (nM - fm) : WGM;
        u.pm = fm + ((wgid % nig) % gsz); u.pn = (wgid % nig) / gsz; u.sel = 0; return ok;
    }
    __device__ __forceinline__ void a_ready(const Unit&) const {}
    __device__ __forceinline__ void done(const Unit&) const {}
};

__device__ __forceinline__ unsigned cvt_pk_bf16(float lo, float hi) { unsigned r; asm volatile("v_cvt_pk_bf16_f32 %0, %1, %2" : "=v"(r) : "v"(lo), "v"(hi)); return r; }
template <class Epi, class Sched, bool ALIGN_EPI = false, bool SP2 = false>
__device__ __forceinline__ void gemm_phase(PG8_LAS unsigned char* lds, const Gemm g, const Sched& S, const Epi& E) {
    const int tid = threadIdx.x, wid = __builtin_amdgcn_readfirstlane(tid >> 6), lane = tid & 63, wr = wid >> 2, wc = wid & 3, fr = lane & 15, fq = lane >> 4;
    const int K = g.K, nt = K / BK;
    unsigned voffA[2], voffB[2];
#pragma unroll
    for (int i = 0; i < 2; ++i) { int R, C; stage_rc(tid * 16 + i * 8192, R, C); const int Rb = Epi::PERM ? ((R & ~31) + perm32(R & 31)) : R;
        voffA[i] = (unsigned)(R * K + C) * 2u; voffB[i] = (unsigned)(Rb * K + C) * 2u; }
    const size_t kstep = (size_t)(BK * 2);
    const size_t hstep = (size_t)HALF * K * 2;
    const size_t tstep = 2 * hstep;
    const unsigned ldsw = (unsigned)wid * 1024u;
    const int aoff = lds_byte(wr * 64 + fr, fq * 8), boff = lds_byte(wc * 32 + fr, fq * 8);
#define PG8_SA(b, h) (((b) * 2 + (h)) * HTB)
#define PG8_SB(b, h) ((4 + (b) * 2 + (h)) * HTB)
#define PG8_STAGE(bufoff, gbase, voff) do { _Pragma("unroll") for (int _i = 0; _i < 2; ++_i) \
        __builtin_amdgcn_global_load_lds((const unsigned*)((const char*)(gbase) + (voff)[_i]), (PG8_LAS unsigned*)(lds + (bufoff) + ldsw + _i * 8192), 16, 0, 0); } while (0)
#define PG8_LDA(dst, b, h) do { _Pragma("unroll") for (int m = 0; m < 4; ++m) _Pragma("unroll") for (int k = 0; k < 2; ++k) dst[m][k] = *(const PG8_LAS bf16x8*)(lds + PG8_SA(b, h) + aoff + m * 2048 + k * 1024); } while (0)
#define PG8_LDB(dst, b, h) do { _Pragma("unroll") for (int n = 0; n < 2; ++n) _Pragma("unroll") for (int k = 0; k < 2; ++k) dst[n][k] = *(const PG8_LAS bf16x8*)(lds + PG8_SB(b, h) + boff + n * 2048 + k * 1024); } while (0)
#define PG8_MMA(ai, bj, At, Bt) do { __builtin_amdgcn_s_setprio(1); _Pragma("unroll") for (int m = 0; m < 4; ++m) _Pragma("unroll") for (int n = 0; n < 2; ++n) _Pragma("unroll") for (int k = 0; k < 2; ++k) \
        acc[ai][bj][m][n] = __builtin_amdgcn_mfma_f32_16x16x32_bf16(Bt[n][k], At[m][k], acc[ai][bj][m][n], 0, 0, 0); __builtin_amdgcn_s_setprio(0); } while (0)
#define PG8_WAIT_V(n) asm volatile("s_waitcnt vmcnt(" #n ")" ::: "memory")
#define PG8_WAIT_L(n) asm volatile("s_waitcnt lgkmcnt(" #n ")" ::: "memory")
#define PG8_BAR __builtin_amdgcn_s_barrier()
#define PG8_SCHED __builtin_amdgcn_sched_barrier(0)
    Unit cur, nxt; int ui = 0;
    if (!S.next(0, cur)) return;
    f32x4 acc[2][2][4][2];
#pragma unroll
    for (int a = 0; a < 2; ++a)
#pragma unroll
        for (int b = 0; b < 2; ++b)
#pragma unroll
            for (int m = 0; m < 4; ++m)
#pragma unroll
                for (int n = 0; n < 2; ++n) acc[a][b][m][n] = (f32x4){0.f, 0.f, 0.f, 0.f};
    bf16x8 At[4][2], B0[2][2], B1[2][2];
    const char* cA = (const char*)((cur.sel & 1) ? g.A1 : g.A0) + (size_t)cur.pm * tstep; const char* cB = (const char*)((cur.sel & 1) ? g.B1 : g.B0) + (size_t)cur.pn * tstep;
    S.a_ready(cur);
    if constexpr (SP2) {
        PG8_STAGE(PG8_SB(0, 0), cB, voffB); PG8_STAGE(PG8_SB(0, 1), cB + hstep, voffB); PG8_STAGE(PG8_SA(0, 0), cA, voffA); PG8_STAGE(PG8_SA(0, 1), cA + hstep, voffA);
        if (wr == 1) PG8_BAR;
        PG8_WAIT_V(2); PG8_BAR;
        PG8_STAGE(PG8_SB(1, 0), cB + kstep, voffB); PG8_STAGE(PG8_SA(1, 0), cA + kstep, voffA); PG8_STAGE(PG8_SB(1, 1), cB + hstep + kstep, voffB);
        PG8_WAIT_V(6); PG8_BAR;
    } else {
        PG8_STAGE(PG8_SB(0, 0), cB, voffB); PG8_STAGE(PG8_SA(0, 0), cA, voffA); PG8_STAGE(PG8_SB(0, 1), cB + hstep, voffB); PG8_STAGE(PG8_SA(0, 1), cA + hstep, voffA);
        if (wr == 1) PG8_BAR;
        PG8_WAIT_V(4); PG8_BAR;
        PG8_STAGE(PG8_SB(1, 0), cB + kstep, voffB); PG8_STAGE(PG8_SA(1, 0), cA + kstep, voffA); PG8_STAGE(PG8_SB(1, 1), cB + hstep + kstep, voffB);
        PG8_WAIT_V(6); PG8_BAR;
    }
    for (;;) {
        const bool has_next = S.next(ui + 1, nxt);
        const char* nA = has_next ? (const char*)((nxt.sel & 1) ? g.A1 : g.A0) + (size_t)nxt.pm * tstep : cA; const char* nB = has_next ? (const char*)((nxt.sel & 1) ? g.B1 : g.B0) + (size_t)nxt.pn * tstep : cB;
        for (int t = 0; t < nt; t += 2) {
            const bool last = (t == nt - 2);
            const char* a1 = cA + (size_t)(t + 1) * kstep;
            const char* a2 = last ? nA : cA + (size_t)(t + 2) * kstep; const char* b2 = last ? nB : cB + (size_t)(t + 2) * kstep;
            const char* a3 = a2 + kstep; const char* b3 = b2 + kstep;
            if (last && has_next) S.a_ready(nxt);
            if constexpr (SP2) {
            PG8_LDB(B0, 0, 0); PG8_LDB(B1, 0, 1); PG8_SCHED; PG8_LDA(At, 0, 0); PG8_STAGE(PG8_SA(1, 1), a1 + hstep, voffA);
            PG8_WAIT_V(8); PG8_WAIT_L(0); PG8_BAR; PG8_MMA(0, 0, At, B0); PG8_MMA(0, 1, At, B1); PG8_BAR; PG8_SCHED;
            PG8_LDA(At, 0, 1); PG8_STAGE(PG8_SB(0, 0), b2, voffB); PG8_STAGE(PG8_SB(0, 1), b2 + hstep, voffB); PG8_STAGE(PG8_SA(0, 0), a2, voffA);
            PG8_WAIT_V(8); PG8_WAIT_L(0); PG8_BAR; PG8_MMA(1, 0, At, B0); PG8_MMA(1, 1, At, B1); PG8_BAR; PG8_SCHED;
            PG8_LDB(B0, 1, 0); PG8_LDB(B1, 1, 1); PG8_SCHED; PG8_LDA(At, 1, 0); PG8_STAGE(PG8_SA(0, 1), a2 + hstep, voffA);
            PG8_WAIT_V(8); PG8_WAIT_L(0); PG8_BAR; PG8_MMA(0, 0, At, B0); PG8_MMA(0, 1, At, B1); PG8_BAR; PG8_SCHED;
            PG8_LDA(At, 1, 1); PG8_STAGE(PG8_SB(1, 0), b3, voffB); PG8_STAGE(PG8_SB(1, 1), b3 + hstep, voffB); PG8_STAGE(PG8_SA(1, 0), a3, voffA);
            PG8_WAIT_V(8); PG8_WAIT_L(0); PG8_BAR; PG8_MMA(1, 0, At, B0); PG8_MMA(1, 1, At, B1); PG8_BAR; PG8_SCHED;
            } else {
            PG8_LDB(B0, 0, 0); PG8_SCHED; PG8_LDA(At, 0, 0); PG8_STAGE(PG8_SA(1, 1), a1 + hstep, voffA);
            PG8_WAIT_L(8); PG8_BAR; PG8_WAIT_L(0); PG8_MMA(0, 0, At, B0); PG8_BAR; PG8_SCHED;
            PG8_LDB(B1, 0, 1); PG8_STAGE(PG8_SB(0, 0), b2, voffB);
            PG8_BAR; PG8_WAIT_L(0); PG8_MMA(0, 1, At, B1); PG8_BAR;
            PG8_LDA(At, 0, 1); PG8_STAGE(PG8_SA(0, 0), a2, voffA);
            PG8_BAR; PG8_WAIT_L(0); PG8_MMA(1, 0, At, B0); PG8_BAR; PG8_SCHED;
            PG8_STAGE(PG8_SB(0, 1), b2 + hstep, voffB);
            PG8_WAIT_V(6); PG8_BAR; PG8_MMA(1, 1, At, B1); PG8_BAR;
            PG8_LDB(B0, 1, 0); PG8_SCHED; PG8_LDA(At, 1, 0); PG8_STAGE(PG8_SA(0, 1), a2 + hstep, voffA);
            PG8_WAIT_L(8); PG8_BAR; PG8_WAIT_L(0); PG8_MMA(0, 0, At, B0); PG8_BAR; PG8_SCHED;
            PG8_LDB(B1, 1, 1); PG8_STAGE(PG8_SB(1, 0), b3, voffB);
            PG8_BAR; PG8_WAIT_L(0); PG8_MMA(0, 1, At, B1); PG8_BAR;
            PG8_LDA(At, 1, 1); PG8_STAGE(PG8_SA(1, 0), a3, voffA);
            PG8_BAR; PG8_WAIT_L(0); PG8_MMA(1, 0, At, B0); PG8_BAR; PG8_SCHED;
            PG8_STAGE(PG8_SB(1, 1), b3 + hstep, voffB);
            PG8_WAIT_V(6); PG8_BAR; PG8_MMA(1, 1, At, B1); PG8_BAR;
            }
        }
        if constexpr (ALIGN_EPI) { if (wr == 0) PG8_BAR; }
        if constexpr (!Epi::AFTER_DRAIN) { E(acc, cur, wr, wc, fr, fq); S.done(cur); }
        if (!has_next) break;
#pragma unroll
        for (int a = 0; a < 2; ++a)
#pragma unroll
            for (int b = 0; b < 2; ++b)
#pragma unroll
                for (int m = 0; m < 4; ++m)
#pragma unroll
                    for (int n = 0; n < 2; ++n) acc[a][b][m][n] = (f32x4){0.f, 0.f, 0.f, 0.f};
        cur = nxt; cA = nA; cB = nB; ++ui;
        if constexpr (ALIGN_EPI) { if (wr == 1) PG8_BAR; }
    }
    PG8_WAIT_V(0);
    if constexpr (!ALIGN_EPI) { if (wr == 0) PG8_BAR; }
    PG8_BAR;
    if constexpr (Epi::AFTER_DRAIN) { E.fused(acc, cur, wr, wc, fr, fq, lds, wid, lane); S.done(cur); }
#undef PG8_SA
#undef PG8_SB
#undef PG8_STAGE
#undef PG8_LDA
#undef PG8_LDB
#undef PG8_MMA
#undef PG8_WAIT_V
#undef PG8_WAIT_L
#undef PG8_BAR
#undef PG8_SCHED
}
}
#define GAS __attribute__((address_space(1)))
#define LAS __attribute__((address_space(3)))
typedef unsigned v4u __attribute__((ext_vector_type(4)));
typedef float f32x4 __attribute__((ext_vector_type(4)));
typedef short bf16x8 __attribute__((ext_vector_type(8)));
typedef GAS unsigned gu32;
typedef GAS unsigned long long gu64;
#define RLX_AGENT __ATOMIC_RELAXED, __HIP_MEMORY_SCOPE_AGENT
#define LDS_WAIT() asm volatile("s_waitcnt lgkmcnt(0)" ::: "memory")
#define VM_WAIT() asm volatile("s_waitcnt vmcnt(0)" ::: "memory")
__device__ __forceinline__ unsigned long long rt() { return __builtin_amdgcn_s_memrealtime(); }
__device__ __forceinline__ unsigned pk2(float lo, float hi) { return (unsigned)f2bf(lo) | ((unsigned)f2bf(hi) << 16); }

#define XB_TMO      128
#define XB_XCNT(j)  (256  + 64 * (j))
#define XB_XSUB(j)  (1280 + 64 * (j))
#define XB_XGEN(j)  (2304 + 64 * (j))
#define XB_TOP      3328
#define XB_TOPGEN   3392
#define XCD_BAR_WORDS 3456
#define XB_SPIN_CAP (1u << 22)

__device__ __forceinline__ unsigned xb_ld(unsigned* p)              { return __hip_atomic_load(p, __ATOMIC_RELAXED, __HIP_MEMORY_SCOPE_AGENT); }
__device__ __forceinline__ unsigned xb_add(unsigned* p, unsigned v) { return __hip_atomic_fetch_add(p, v, __ATOMIC_RELAXED, __HIP_MEMORY_SCOPE_AGENT); }
__device__ __forceinline__ unsigned xb_xcc_id() { return (unsigned)__builtin_amdgcn_s_getreg((3 << 11) | 20) & 0xFu; }
#define XB_SPIN(cond, bar) do { unsigned _sp = 0; while (cond) { __builtin_amdgcn_s_sleep(1); \
    if ((++_sp & 255u) == 0u) { if (xb_ld(&(bar)[XB_TMO])) break; if (_sp > XB_SPIN_CAP) { atomicAdd(&(bar)[XB_TMO], 1u); break; } } } } while (0)

struct XcdBarrier {
    unsigned* bar; unsigned x;
    volatile LAS unsigned* st;
};

__device__ __forceinline__ XcdBarrier xcd_barrier_post(unsigned* bar, volatile LAS unsigned* st) {
    XcdBarrier b; b.bar = bar; b.x = xb_xcc_id(); b.st = st;
    if (threadIdx.x == 0) (void)xb_add(&bar[XB_XCNT(b.x)], 1u);
    return b;
}
__device__ __forceinline__ void xcd_barrier_complete(unsigned* bar, unsigned x, unsigned& nloc, unsigned& nx) {
    const unsigned G = gridDim.x * gridDim.y * gridDim.z;
    unsigned sum, cnt, mine, sp = 0u;
    for (;;) {
        sum = 0u; cnt = 0u; mine = 0u;
#pragma unroll
        for (unsigned j = 0; j < 16; ++j) { const unsigned c = xb_ld(&bar[XB_XCNT(j)]); sum += c; cnt += (c > 0u) ? 1u : 0u; mine = (j == x) ? c : mine; }
        if (sum == G) break;
        __builtin_amdgcn_s_sleep(1);
        if ((++sp & 255u) == 0u) { if (xb_ld(&bar[XB_TMO])) break; if (sp > XB_SPIN_CAP) { atomicAdd(&bar[XB_TMO], 1u); break; } }
    }
    nloc = mine > 0u ? mine : 1u; nx = cnt > 0u ? cnt : 1u;
}

__device__ __forceinline__ void xcd_barrier(const XcdBarrier& b) {
    asm volatile("s_waitcnt vmcnt(0)" ::: "memory");
    __syncthreads();
    if (threadIdx.x == 0) {
        unsigned* bar = b.bar;
        __builtin_amdgcn_s_waitcnt(0);
        unsigned nloc = b.st[0], nx = b.st[1];
        if (nloc == 0u) { xcd_barrier_complete(bar, b.x, nloc, nx); b.st[0] = nloc; b.st[1] = nx; }
        const unsigned old = xb_add(&bar[XB_XSUB(b.x)], 1u);
        const unsigned gen = old / nloc;
        if (old + 1u == (gen + 1u) * nloc) {
            __builtin_amdgcn_fence(__ATOMIC_RELEASE, "agent");
            asm volatile("s_waitcnt vmcnt(0)" ::: "memory");
            const unsigned og = xb_add(&bar[XB_TOP], 1u);
            const unsigned tg = og / nx;
            if (og + 1u == (tg + 1u) * nx) xb_add(&bar[XB_TOPGEN], 1u);
            else XB_SPIN(xb_ld(&bar[XB_TOPGEN]) == tg, bar);
            __builtin_amdgcn_fence(__ATOMIC_ACQUIRE, "agent");
            xb_add(&bar[XB_XGEN(b.x)], 1u);
            asm volatile("s_waitcnt vmcnt(0)" ::: "memory");
        } else {
            XB_SPIN(xb_ld(&bar[XB_XGEN(b.x)]) == gen, bar);
            __builtin_amdgcn_fence(__ATOMIC_ACQUIRE, "agent");
            asm volatile("s_waitcnt vmcnt(0)" ::: "memory");
        }
    }
    __syncthreads();
}
namespace ep {
using pg8::f32x4; using pg8::u32x4; using pg8::Unit; using pg8::cvt_pk_bf16;
__device__ __forceinline__ float fsig(float v) { return __builtin_amdgcn_rcpf(1.f + __builtin_amdgcn_exp2f(-1.4426950408889634f * v)); }
__device__ __forceinline__ f32x4 act4(f32x4 v, int mode) {
    if (mode == 0) return v;
    f32x4 s; s[0] = fsig(v[0]); s[1] = fsig(v[1]); s[2] = fsig(v[2]); s[3] = fsig(v[3]);
    return mode == 1 ? v * s : s;
}
__device__ __forceinline__ u32x4 pack8(f32x4 a, f32x4 b) { u32x4 w; w.x = cvt_pk_bf16(a[0], a[1]); w.y = cvt_pk_bf16(a[2], a[3]); w.z = cvt_pk_bf16(b[0], b[1]); w.w = cvt_pk_bf16(b[2], b[3]); return w; }
__device__ __forceinline__ float lo16(unsigned w) { return __uint_as_float(w << 16); }
__device__ __forceinline__ float hi16(unsigned w) { return __uint_as_float(w & 0xffff0000u); }

struct EpiIn {
    static constexpr bool PERM = true, AFTER_DRAIN = false;
    unsigned char* ws; const float* q_g; const float* k_g; const float* b_if;
    __device__ __forceinline__ void operator()(const f32x4 (&acc)[2][2][4][2], const Unit& u, int wr, int wc, int fr, int fq) const {
        const int pn = u.pn; const int row0 = u.pm * 256 + wr * 64 + fr;
        if (pn < 4) {
            const bool isq = pn < 2;
            bf16_t* dst = (bf16_t*)(ws + (isq ? WS_Q : WS_K)) + (pn & 1) * 256 + 64 * wc + 8 * fq;
            const float* g = isq ? q_g : k_g;
            f32x4 gv[2][2];
#pragma unroll
            for (int bj = 0; bj < 2; ++bj)
#pragma unroll
                for (int n = 0; n < 2; ++n) gv[bj][n] = *(const f32x4*)(g + 32 * bj + 16 * n + 4 * fq);
            const float* rope = (const float*)(ws + WS_ROPE) + 4 * fq;
            const bool lat = u.pm < 128; const float sc = isq ? C2 : 1.f;
#pragma unroll
            for (int ai = 0; ai < 2; ++ai) {
                f32x4 rp4[4][4];
                if (lat) {
#pragma unroll
                    for (int m = 0; m < 4; ++m) { const int t = (row0 + ai * 128 + m * 16) & (SEQ - 1), rid = t >> 6, cid = t & 63;
                        rp4[m][0] = *(const f32x4*)(rope + rid * 16); rp4[m][1] = *(const f32x4*)(rope + 1024 + rid * 16); rp4[m][2] = *(const f32x4*)(rope + cid * 16); rp4[m][3] = *(const f32x4*)(rope + 1024 + cid * 16); }
                }
                asm volatile("" ::: "memory");
#pragma unroll
                for (int m = 0; m < 4; ++m) {
                    const int row = row0 + ai * 128 + m * 16;
                    float ss = 0.f;
#pragma unroll
                    for (int bj = 0; bj < 2; ++bj)
#pragma unroll
                        for (int n = 0; n < 2; ++n) { const f32x4 a = acc[ai][bj][m][n]; ss += (a[0] * a[0] + a[1] * a[1]) + (a[2] * a[2] + a[3] * a[3]); }
                    ss += __shfl_xor(ss, 16); ss += __shfl_xor(ss, 32);
                    const float rn = rsqrtf(ss * (1.f / 64.f) + EPS) * sc;
                    f32x4 y[2][2];
#pragma unroll
                    for (int bj = 0; bj < 2; ++bj)
#pragma unroll
                        for (int n = 0; n < 2; ++n) y[bj][n] = acc[ai][bj][m][n] * rn * gv[bj][n];
                    if (lat) {
                        const f32x4 cr = rp4[m][0], sr = rp4[m][1], cc = rp4[m][2], scn = rp4[m][3];
                        const f32x4 a0 = y[0][0] * cr - y[0][1] * sr, a1 = y[0][0] * sr + y[0][1] * cr;
                        const f32x4 b0 = y[1][0] * cc - y[1][1] * scn, b1 = y[1][0] * scn + y[1][1] * cc;
                        y[0][0] = a0; y[0][1] = a1; y[1][0] = b0; y[1][1] = b1;
                    }
                    bf16_t* rp = dst + (size_t)row * 512;
                    __builtin_nontemporal_store(pack8(y[0][0], y[0][1]), (u32x4*)(rp));
                    __builtin_nontemporal_store(pack8(y[1][0], y[1][1]), (u32x4*)(rp + 32));
                }
                asm volatile("" ::: "memory");
            }
        } else if (pn < 24) {
            size_t off; int ld, cb, mode;
            if (pn < 16) { ld = 512; cb = (pn & 1) * 256; const int s = pn >> 1;
                off = s == 2 ? WS_V : s == 3 ? WS_ZA : s == 4 ? WS_XM : s == 5 ? WS_VM : s == 6 ? WS_ZB : WS_OB;
                mode = (s == 3 || s == 6) ? 1 : (s == 7 ? 2 : 0); }
            else { ld = 1024; cb = ((pn - 16) & 3) * 256; off = pn < 20 ? WS_GA : WS_GB; mode = 2; }
            bf16_t* dst = (bf16_t*)(ws + off) + cb + 32 * wc + 8 * fq;
#pragma unroll
            for (int ai = 0; ai < 2; ++ai)
#pragma unroll
                for (int m = 0; m < 4; ++m) { bf16_t* rp = dst + (size_t)(row0 + ai * 128 + m * 16) * ld;
#pragma unroll
                    for (int bj = 0; bj < 2; ++bj) __builtin_nontemporal_store(pack8(act4(acc[ai][bj][m][0], mode), act4(acc[ai][bj][m][1], mode)), (u32x4*)(rp + bj * 128)); }
        } else {
            if (wc == 0 && fq < 2) {
                float* G = (float*)(ws + WS_GATES) + 8 * fq;
                const f32x4 bi = *(const f32x4*)(b_if + 8 * fq), bf = *(const f32x4*)(b_if + 8 * fq + 4);
#pragma unroll
                for (int ai = 0; ai < 2; ++ai)
#pragma unroll
                    for (int m = 0; m < 4; ++m) { float* rp = G + (size_t)(row0 + ai * 128 + m * 16) * 16;
                        const f32x4 vi = acc[ai][0][m][0] + bi; f32x4 vf = acc[ai][0][m][1] + bf;
#pragma unroll
                        for (int i = 0; i < 4; ++i) { const float x = vf[i]; vf[i] = fminf(x, 0.f) - 0.6931471805599453f * __builtin_amdgcn_logf(1.f + __builtin_amdgcn_exp2f(-1.4426950408889634f * fabsf(x))); }
                        *(f32x4*)rp = vi; *(f32x4*)(rp + 4) = vf; }
            }
        }
    }
};
struct EpiMerge {
    static constexpr bool PERM = true, AFTER_DRAIN = false;
    bf16_t* GA; bf16_t* GB;
    __device__ __forceinline__ void operator()(const f32x4 (&acc)[2][2][4][2], const Unit& u, int wr, int wc, int fr, int fq) const {
        const int row0 = u.pm * 256 + wr * 64 + fr; const int col0 = u.pn * 256 + 32 * wc + 8 * fq; const bool second = (u.sel & 1) != 0; const bool dry = (u.sel & 2) != 0;
        bf16_t* G = second ? GB : GA;
#pragma unroll
        for (int ai = 0; ai < 2; ++ai) {
            u32x4 gwv[4][2], awv[4][2];
#pragma unroll
            for (int m = 0; m < 4; ++m) { const size_t ro = (size_t)(row0 + ai * 128 + m * 16) * 1024 + col0;
#pragma unroll
                for (int bj = 0; bj < 2; ++bj) { gwv[m][bj] = *(const u32x4*)(G + ro + bj * 128); if (second) awv[m][bj] = *(const u32x4*)(GA + ro + bj * 128); } }
            asm volatile("" ::: "memory");
#pragma unroll
            for (int m = 0; m < 4; ++m) { const size_t ro = (size_t)(row0 + ai * 128 + m * 16) * 1024 + col0;
#pragma unroll
                for (int bj = 0; bj < 2; ++bj) { const size_t o = ro + bj * 128; const u32x4 gw = gwv[m][bj];
                    f32x4 g0 = {lo16(gw.x), hi16(gw.x), lo16(gw.y), hi16(gw.y)}, g1 = {lo16(gw.z), hi16(gw.z), lo16(gw.w), hi16(gw.w)};
                    f32x4 v0 = g0 * acc[ai][bj][m][0], v1 = g1 * acc[ai][bj][m][1];
                    if (second) { const u32x4 aw = awv[m][bj];
                        v0 += (f32x4){lo16(aw.x), hi16(aw.x), lo16(aw.y), hi16(aw.y)}; v1 += (f32x4){lo16(aw.z), hi16(aw.z), lo16(aw.w), hi16(aw.w)}; }
                    if (!dry) *(u32x4*)(G + o) = pack8(v0, v1); } }
            asm volatile("" ::: "memory");
        }
    }
};
struct EpiOut {
    static constexpr bool PERM = false, AFTER_DRAIN = false;
    const float* x; const float* mod; float* out;
    __device__ __forceinline__ void operator()(const f32x4 (&acc)[2][2][4][2], const Unit& u, int wr, int wc, int fr, int fq) const {
        const int row0 = u.pm * 256 + wr * 64 + fr; const int col0 = u.pn * 256 + 32 * wc + 4 * fq;
        const float* gt = mod + (size_t)(u.pm >> 3) * 3072 + 2048 + col0;
        f32x4 gv[2][2];
#pragma unroll
        for (int bj = 0; bj < 2; ++bj)
#pragma unroll
            for (int n = 0; n < 2; ++n) gv[bj][n] = *(const f32x4*)(gt + bj * 128 + n * 16);
#pragma unroll
        for (int ai = 0; ai < 2; ++ai) {
            f32x4 xv[4][2][2];
#pragma unroll
            for (int m = 0; m < 4; ++m) { const size_t ro = (size_t)(row0 + ai * 128 + m * 16) * 1024 + col0;
#pragma unroll
                for (int bj = 0; bj < 2; ++bj)
#pragma unroll
                    for (int n = 0; n < 2; ++n) xv[m][bj][n] = *(const f32x4*)(x + ro + bj * 128 + n * 16); }
            asm volatile("" ::: "memory");
#pragma unroll
            for (int m = 0; m < 4; ++m) { const size_t ro = (size_t)(row0 + ai * 128 + m * 16) * 1024 + col0;
#pragma unroll
                for (int bj = 0; bj < 2; ++bj)
#pragma unroll
                    for (int n = 0; n < 2; ++n) *(f32x4*)(out + ro + bj * 128 + n * 16) = xv[m][bj][n] + gv[bj][n] * acc[ai][bj][m][n]; }
            asm volatile("" ::: "memory");
        }
    }
};
struct SchedIn {
    pg8::StaticOrder so; int G, c;
    __device__ void init(int G_, int c_) { so.init(R, 24 * 256, G_, c_); G = G_; c = c_; }
    __device__ __forceinline__ bool next(int i, Unit& u) const {
#if defined(PROBE_DUP) && ((PROBE_DUP >> 2) & 1)
        { const int nr = (3328 + G - 1) / G; if (i >= nr) { if (i >= 2 * nr) return false; i -= nr; } }
#endif
        Unit t; const bool reg = so.next(i, t);
        const int Lp = (int)((long)i * G + c - 3072);
        const bool ok = reg || Lp < 256;
        const int idx = Lp >> 4;
        const int pm2 = Lp < 128 ? 128 + (Lp & 15) : Lp - 128;
        const int pn2 = Lp < 128 ? (idx < 4 ? 2 + idx : 4 + idx) : 24;
        u.pm = reg ? t.pm : pm2; u.pn = reg ? t.pn : pn2; u.sel = 0;
        return ok;
    }
    __device__ __forceinline__ void a_ready(const Unit&) const {}
    __device__ __forceinline__ void done(const Unit&) const {}
};
struct SchedMerge {
    pg8::StaticOrder so;
    __device__ void init(int G_, int c_) { so.init(R, 1024, G_, c_); }
    __device__ __forceinline__ bool next(int i, Unit& u) const { int dry = 0;
#if defined(PROBE_DUP) && ((PROBE_DUP >> 6) & 1)
        { const int nr = 2 * ((512 + so.G - 1) / so.G); if (i >= 2 * nr) return false; if (i < nr) dry = 2; else i -= nr; }
#endif
        Unit t; const bool ok = so.next(i >> 1, t); u.pm = t.pm; u.pn = t.pn; u.sel = (i & 1) | dry; return ok; }
    __device__ __forceinline__ void a_ready(const Unit&) const {}
    __device__ __forceinline__ void done(const Unit&) const {}
};
struct SchedOut {
    pg8::StaticOrder so; int G;
    __device__ void init(int G_, int c_) { so.init(R, 1024, G_, c_); G = G_; }
    __device__ __forceinline__ bool next(int i, Unit& u) const {
#if defined(PROBE_DUP) && ((PROBE_DUP >> 7) & 1)
        { const int nr = (512 + G - 1) / G; if (i >= nr) { if (i >= 2 * nr) return false; i -= nr; } }
#endif
        return so.next(i, u); }
    __device__ __forceinline__ void a_ready(const Unit&) const {}
    __device__ __forceinline__ void done(const Unit&) const {}
};
}

constexpr int NWAVES = 8;
constexpr int RING_OFF = 0, RING_BYTES = 131072;
constexpr int LDSCTL_OFF = 150 * 1024, MISC_OFF = LDSCTL_OFF + 320;
constexpr int LDS_BYTES = 152 * 1024;
typedef unsigned u32x4_t __attribute__((ext_vector_type(4)));
constexpr int CW_TMO = 0, CW_CODE = 1, CW_BAR = 4096;
constexpr size_t CTL_ZERO_BYTES = 256 * 1024;

struct Frame {
    LAS unsigned char* lds; volatile LAS unsigned* MISC; gu32* ctl;
    int tid, lane, wave, vcu, G;
};
__device__ __forceinline__ float wave_sum(float v) {
#pragma unroll
    for (int o = 1; o < 64; o <<= 1) v += __shfl_xor(v, o);
    return v;
}
__device__ __forceinline__ int dmap32(int j) { return 4 * (j >> 3) + (j & 3) + 16 * ((j >> 2) & 1); }
__device__ __forceinline__ void tr_item(const float* W, int ldw, int srccol0, int mode, int valid, bf16_t* WT, int Kd, int dstrow0, int k0, LAS float* scr, int lane, float scale = 1.f) {
    const int cl = lane & 31;
    float wv[32];
#pragma unroll
    for (int i = 0; i < 32; ++i) { const int kk = 2 * i + (lane >> 5); wv[i] = cl < valid ? __builtin_nontemporal_load(W + (size_t)(k0 + kk) * ldw + srccol0 + cl) : 0.f; }
#pragma unroll
    for (int i = 0; i < 32; ++i) { const int kk = 2 * i + (lane >> 5); scr[kk * 33 + cl] = wv[i] * scale; }
    LDS_WAIT(); asm volatile("" ::: "memory");
    const int c = lane & 7;
#pragma unroll
    for (int j = 0; j < 4; ++j) { const int n = (lane >> 3) + 8 * j; const int sn = mode ? dmap32(n) : n; const LAS float* s = scr + (8 * c) * 33 + sn;
        v4u o; o.x = pk2(s[0 * 33], s[1 * 33]); o.y = pk2(s[2 * 33], s[3 * 33]); o.z = pk2(s[4 * 33], s[5 * 33]); o.w = pk2(s[6 * 33], s[7 * 33]);
        *(GAS v4u*)(WT + (size_t)(dstrow0 + n) * Kd + k0 + 8 * c) = o; }
    LDS_WAIT(); asm volatile("" ::: "memory");
}
__device__ __forceinline__ void p_transposes(Frame& F, const P& p) {
    LAS float* scr = (LAS float*)(F.lds + RING_OFF + F.wave * 16384);
    const int gw = F.vcu * NWAVES + F.wave, NGW = F.G * NWAVES;
    bf16_t* WTIN = (bf16_t*)(p.ws + WS_WTIN); bf16_t* WTOA = (bf16_t*)(p.ws + WS_WTOA); bf16_t* WTOB = (bf16_t*)(p.ws + WS_WTOB); bf16_t* WTO = (bf16_t*)(p.ws + WS_WTO);
    constexpr int I_IN = 16 * 200, I_OA = 8 * 32, I_O = 16 * 32, I_M = 64, NITEMS = I_IN + 2 * I_OA + I_O + I_M;
    for (int it = gw; it < NITEMS; it += NGW) {
        int r = it;
        if (r < I_IN) { const int kb = r / 200, nb = r % 200; int src, mode = 0, valid = 32;
            if (nb < 32) { const int tile = nb >> 3, bj = (nb & 7) >> 2, wc = nb & 3; src = 256 * tile + 64 * wc + 32 * bj; mode = 1; }
            else if (nb < 128) src = 32 * nb;
            else if (nb < 192) src = 32 * nb + 16;
            else { src = 4096; valid = nb == 192 ? 16 : 0; }
            tr_item(p.w_in, INW, src, mode, valid, WTIN, 1024, 32 * nb, 64 * kb, scr, F.lane); continue; }
        r -= I_IN;
        if (r < I_OA) { tr_item(p.w_out_a, 1024, 32 * (r % 32), 0, 32, WTOA, 512, 32 * (r % 32), 64 * (r / 32), scr, F.lane); continue; }
        r -= I_OA;
        if (r < I_OA) { tr_item(p.w_out_b, 1024, 32 * (r % 32), 0, 32, WTOB, 512, 32 * (r % 32), 64 * (r / 32), scr, F.lane); continue; }
        r -= I_OA;
        if (r < I_O) { tr_item(p.w_o, 1024, 32 * (r % 32), 0, 32, WTO, 1024, 32 * (r % 32), 64 * (r / 32), scr, F.lane); continue; }
        r -= I_O;
        { const int mat = r >> 5, hh = (r >> 3) & 3, kb = (r >> 2) & 1, nb = r & 3;
          tr_item((mat ? p.wk : p.wq) + hh * 16384, 128, 32 * nb, 0, 32, (bf16_t*)(p.ws + WS_MWQ) + mat * 65536 + hh * 16384, 128, 32 * nb, 64 * kb, scr, F.lane, mat ? 0.08838834764831845f : 1.f); }
    }
}
__device__ __forceinline__ void p0_prologue(Frame& F, const P& p) {
    float* rope = (float*)(p.ws + WS_ROPE);
    if (F.vcu == F.G - 1) {
        for (int i = F.tid; i < 1024; i += NWAVES * 64) { const int pos = i >> 4, f = i & 15; const float inv = powf(10000.0f, -(float)f / 16.0f); const float a = (float)pos * inv; rope[i] = cosf(a); rope[1024 + i] = sinf(a); }
        if (F.wave == 0) { const float s1 = wave_sum(p.lq1[F.lane] * p.lk1[F.lane]), s2 = wave_sum(p.lq2[F.lane] * p.lk2[F.lane]);
            float gq = fabsf(p.q_g[F.lane]), gk = fabsf(p.k_g[F.lane]);
#pragma unroll
            for (int o = 1; o < 64; o <<= 1) { gq = fmaxf(gq, __shfl_xor(gq, o)); gk = fmaxf(gk, __shfl_xor(gk, o)); }
            if (F.lane == 0) { rope[2048] = expf(s1) - expf(s2) + LAM_INIT; rope[2049] = fminf(C2 * 64.f * gq * gk, 60.f); } }
    }
    for (int grp = F.vcu; grp < 96; grp += F.G) {
        LAS float* sc = (LAS float*)(F.lds + RING_OFF);
        LAS float* red = sc + 17 * 1024;
        __syncthreads();
        for (int i = F.tid; i < 17 * 1024; i += NWAVES * 64) { const int b = i >> 10, k = i & 1023; const float v = b < 16 ? p.c[b * 1024 + k] : p.c_ctx[k]; sc[i] = v * ep::fsig(v); }
        __syncthreads();
        const int cl = F.lane & 31, col = grp * 32 + cl, k0 = F.wave * 128 + (F.lane >> 5) * 64;
        float acc[17];
#pragma unroll
        for (int b = 0; b < 17; ++b) acc[b] = 0.f;
#pragma unroll 32
        for (int k = k0; k < k0 + 64; ++k) { const float w = __builtin_nontemporal_load(p.w_mod + (size_t)k * 3072 + col);
#pragma unroll
            for (int b = 0; b < 17; ++b) acc[b] += sc[b * 1024 + k] * w; }
#pragma unroll
        for (int b = 0; b < 17; ++b) { acc[b] += __shfl_xor(acc[b], 32); if (F.lane < 32) red[(F.wave * 17 + b) * 32 + cl] = acc[b]; }
        __syncthreads();
        float* mod = (float*)(p.ws + WS_MOD);
        for (int i = F.tid; i < 17 * 32; i += NWAVES * 64) { const int b = i >> 5, cc = i & 31; float s = p.b_mod[grp * 32 + cc];
#pragma unroll
            for (int w = 0; w < 8; ++w) s += red[(w * 17 + b) * 32 + cc];
            mod[b * 3072 + grp * 32 + cc] = s; }
    }
    __syncthreads();
}
__device__ __forceinline__ void p1_hrows(Frame& F, const P& p) {
    const int gw = F.vcu * NWAVES + F.wave, NGW = F.G * NWAVES;
    LAS float* wg = (LAS float*)(F.lds + RING_OFF);
    __syncthreads();
    for (int kk = F.tid; kk < 1024; kk += NWAVES * 64) { const f32x4* src = (const f32x4*)(p.w_in + (size_t)kk * INW + 4096);
#pragma unroll
        for (int q = 0; q < 4; ++q) { const f32x4 v = src[q]; wg[(4 * q) * 1024 + kk] = v.x; wg[(4 * q + 1) * 1024 + kk] = v.y; wg[(4 * q + 2) * 1024 + kk] = v.z; wg[(4 * q + 3) * 1024 + kk] = v.w; } }
    __syncthreads();
    const float* mod = (const float*)(p.ws + WS_MOD); bf16_t* H = (bf16_t*)(p.ws + WS_H);
    f32x4 nw[4];
#pragma unroll
    for (int j = 0; j < 4; ++j) nw[j] = ((const f32x4*)p.norm_w)[F.lane + 64 * j];
    for (int row = gw; row < RC; row += NGW) {
        const float* xr; int b;
        if (row < R) { xr = p.x + (size_t)row * 1024; b = row >> 11; } else { xr = p.ctx + (size_t)(row - R) * 1024; b = 16; }
        const f32x4* xv = (const f32x4*)xr + F.lane; const f32x4* sh = (const f32x4*)(mod + b * 3072) + F.lane; const f32x4* sc = (const f32x4*)(mod + b * 3072 + 1024) + F.lane;
        f32x4 v[4]; float s = 0.f;
#pragma unroll
        for (int j = 0; j < 4; ++j) { v[j] = __builtin_nontemporal_load(xv + 64 * j); s += (v[j].x * v[j].x + v[j].y * v[j].y) + (v[j].z * v[j].z + v[j].w * v[j].w); }
        const float rn = rsqrtf(wave_sum(s) * (1.f / 1024.f) + EPS);
        unsigned long long* o8 = (unsigned long long*)(H + (size_t)row * 1024) + F.lane;
        f32x4 y[4];
#pragma unroll
        for (int j = 0; j < 4; ++j) { y[j] = v[j] * rn * nw[j] * (sc[64 * j] + 1.f) + sh[64 * j];
            o8[64 * j] = (unsigned long long)pg8::cvt_pk_bf16(y[j].x, y[j].y) | ((unsigned long long)pg8::cvt_pk_bf16(y[j].z, y[j].w) << 32); }
        if (row >= R) {
            float mine = 0.f;
#pragma unroll
            for (int g = 0; g < 16; ++g) { float s = 0.f;
#pragma unroll
                for (int j = 0; j < 4; ++j) { const f32x4 w = *(const LAS f32x4*)(wg + g * 1024 + 4 * F.lane + 256 * j); s += (y[j].x * w.x + y[j].y * w.y) + (y[j].z * w.z + y[j].w * w.w); }
                s = wave_sum(s); if (F.lane == g) mine = s; }
            if (F.lane < 16) { float s = mine + p.b_if[F.lane]; if ((F.lane >> 2) & 1) s = fminf(s, 0.f) - log1pf(expf(-fabsf(s)));
                ((float*)(p.ws + WS_GATES))[(size_t)row * 16 + F.lane] = s; }
        }
    }
    __syncthreads();
}


namespace att {
using bf16x8 = __attribute__((ext_vector_type(8))) short;
using s16x4 = __attribute__((ext_vector_type(4))) short;
using f32x16 = __attribute__((ext_vector_type(16))) float;
using u32x4 = __attribute__((ext_vector_type(4))) unsigned;
typedef short v4i16_t __attribute__((ext_vector_type(4)));
typedef float f32x2_t __attribute__((ext_vector_type(2))); typedef __bf16 bf16x2_t __attribute__((ext_vector_type(2)));
constexpr int SLOT = 16384, LDS_K = 0, LDS_V = 3 * SLOT, LDS_WS = 6 * SLOT, NT = NKEY / 64, STLD = 132;
__device__ __forceinline__ int crow(int r, int hi) { return (r & 3) + 8 * (r >> 2) + 4 * hi; }
__device__ __forceinline__ void glds16(const void* gsrc, unsigned lds_dst) { unsigned keep;
    asm volatile("s_mov_b32 %0, m0\n\ts_mov_b32 m0, %2\n\ts_nop 0\n\tglobal_load_lds_dwordx4 %1, off\n\ts_mov_b32 m0, %0" : "=&s"(keep) : "v"(gsrc), "s"(lds_dst) : "memory"); }
__device__ __forceinline__ unsigned cvtpk_s(float lo, float hi) { f32x2_t v = {lo, hi}; bf16x2_t b = __builtin_convertvector(v, bf16x2_t); return __builtin_bit_cast(unsigned, b); }
typedef LAS const char* lds_cptr;
__device__ __forceinline__ s16x4 vtr(lds_cptr p) { return __builtin_bit_cast(s16x4, __builtin_amdgcn_ds_read_tr16_b64_v4i16((LAS v4i16_t*)p)); }
#define ATT_WAIT_BAR(N) asm volatile("s_waitcnt vmcnt(" #N ") lgkmcnt(0)\n\ts_barrier" ::: "memory")
#define ATT_MFMA(a, b, c) __builtin_amdgcn_mfma_f32_32x32x16_bf16(a, b, c, 0, 0, 0)

__device__ __forceinline__ void attn_unit(int b, int h, int qb, const P& p, LAS unsigned char* shm, float lam, float Mref, bool dry) {
    const int tid = threadIdx.x, lane = tid & 63, r32 = lane & 31, hi = lane >> 5; const int wid = __builtin_amdgcn_readfirstlane(tid >> 6);
    const int map = wid >> 2, qsub = wid & 3;
    bf16_t* Qb = (bf16_t*)(p.ws + WS_Q); const bf16_t* Kb = (const bf16_t*)(p.ws + WS_K); const bf16_t* Vb = (const bf16_t*)(p.ws + WS_V);
    const size_t qrow0 = (size_t)b * SEQ + qb * 128;
    bf16x8 qr[4];
    { const bf16_t* Qw = Qb + (qrow0 + qsub * 32 + r32) * 512 + h * 128 + map * 64 + hi * 8;
#pragma unroll
      for (int d0 = 0; d0 < 4; ++d0) qr[d0] = *(const bf16x8*)(Qw + d0 * 16); }
    const unsigned lds0 = (unsigned)(uintptr_t)shm;
    const bf16_t* ksrc = Kb + (size_t)lane * 512 + h * 128 + wid * 8;
    const bf16_t* vsrc = Vb + (size_t)(16 * (wid & 3) + (lane >> 2)) * 512 + h * 128 + (wid >> 2) * 32 + (lane & 3) * 8;
    const unsigned kdst = lds0 + LDS_K + wid * 1024, vdst = lds0 + LDS_V + (wid >> 2) * 4096 + (wid & 3) * 1024;
#define ATT_TROW(t) ((t) < 4 ? (size_t)R + (size_t)b * CTX + (size_t)(t) * 64 : (size_t)b * SEQ + (size_t)((t) - 4) * 64)
#define ATT_DMA(t, slot) do { const size_t ro_ = ATT_TROW(t) * 512; \
        glds16(ksrc + ro_, (unsigned)__builtin_amdgcn_readfirstlane(kdst + (slot))); glds16(ksrc + ro_ + 64, (unsigned)__builtin_amdgcn_readfirstlane(kdst + (slot) + 8192)); \
        glds16(vsrc + ro_, (unsigned)__builtin_amdgcn_readfirstlane(vdst + (slot))); glds16(vsrc + ro_ + 64, (unsigned)__builtin_amdgcn_readfirstlane(vdst + (slot) + 8192)); } while (0)
    ATT_DMA(0, 0); ATT_DMA(1, SLOT);
    const lds_cptr shm3 = (lds_cptr)shm;
    const lds_cptr kp0 = shm3 + LDS_K + map * 8192 + hi * 1024 + r32 * 16;
    const lds_cptr vp0 = shm3 + LDS_V + ((lane >> 4) & 1) * 32 + (lane & 3) * 8 + (4 * hi + ((lane & 15) >> 2)) * 64;
    f32x16 o[4]; o[0] = f32x16{}; o[1] = f32x16{}; o[2] = f32x16{}; o[3] = f32x16{};
    f32x16 negm;
#pragma unroll
    for (int r = 0; r < 16; ++r) negm[r] = -Mref;
    float l_reg = 0.f;
    ATT_WAIT_BAR(4);
    int sl_cur = 0, sl_n2 = 2 * SLOT;
    for (int t = 0; t < NT; ++t) {
        if (t + 2 < NT) ATT_DMA(t + 2, sl_n2);
        const lds_cptr kp = kp0 + sl_cur, vp = vp0 + sl_cur;
        f32x16 p0, p1;
#pragma unroll
        for (int d0 = 0; d0 < 4; ++d0) {
            const bf16x8 b0 = *(const LAS bf16x8*)(kp + d0 * 2048), b1 = *(const LAS bf16x8*)(kp + d0 * 2048 + 512);
            if (d0 == 0) { p0 = ATT_MFMA(b0, qr[0], negm); p1 = ATT_MFMA(b1, qr[0], negm); }
            else { p0 = ATT_MFMA(b0, qr[d0], p0); p1 = ATT_MFMA(b1, qr[d0], p1); }
        }
        float sacc = 0.f;
#pragma unroll
        for (int r = 0; r < 16; ++r) { p0[r] = __builtin_amdgcn_exp2f(p0[r]); p1[r] = __builtin_amdgcn_exp2f(p1[r]); sacc += p0[r] + p1[r]; }
        l_reg += sacc;
        u32x4 pw[4];
#pragma unroll
        for (int k = 0; k < 4; ++k) { pw[0][k] = cvtpk_s(p0[2 * k], p0[2 * k + 1]); pw[1][k] = cvtpk_s(p0[8 + 2 * k], p0[9 + 2 * k]); pw[2][k] = cvtpk_s(p1[2 * k], p1[2 * k + 1]); pw[3][k] = cvtpk_s(p1[8 + 2 * k], p1[9 + 2 * k]); }
#pragma unroll
        for (int d0 = 0; d0 < 4; ++d0)
#pragma unroll
            for (int ks = 0; ks < 4; ++ks) {
                const s16x4 lo = vtr(vp + d0 * 4096 + ks * 1024), hh = vtr(vp + d0 * 4096 + ks * 1024 + 512);
                const bf16x8 vf = (bf16x8){lo[0], lo[1], lo[2], lo[3], hh[0], hh[1], hh[2], hh[3]};
                o[d0] = ATT_MFMA(__builtin_bit_cast(bf16x8, pw[ks]), vf, o[d0]);
            }
        if (t + 2 < NT) { ATT_WAIT_BAR(4); } else { ATT_WAIT_BAR(0); }
        sl_n2 = sl_cur; sl_cur = (sl_cur == 2 * SLOT) ? 0 : sl_cur + SLOT;
    }
    const size_t go = (qrow0 + (tid >> 2)) * 512 + h * 128 + (tid & 3) * 32;
    u32x4 zwv[4];
    { const bf16_t* za = (const bf16_t*)(p.ws + WS_ZA) + go;
#pragma unroll
      for (int i = 0; i < 4; ++i) zwv[i] = *(const u32x4*)(za + 8 * i); }
    LAS float* wsf = (LAS float*)(shm + LDS_WS) + wid * 64;
    { auto rr = __builtin_amdgcn_permlane32_swap(__float_as_uint(l_reg), __float_as_uint(l_reg), false, false); l_reg = __uint_as_float(rr[0]) + __uint_as_float(rr[1]); }
    if (hi == 0) wsf[r32] = l_reg;
    asm volatile("s_waitcnt lgkmcnt(0)" ::: "memory");
    float scl[16];
#pragma unroll
    for (int r = 0; r < 16; ++r) scl[r] = __builtin_amdgcn_rcpf(wsf[crow(r, hi)]) * (map ? lam : 1.f);
    LAS float* stage = (LAS float*)shm;
    const int qloc = qsub * 32;
    if (map == 1) {
#pragma unroll
        for (int d0 = 0; d0 < 4; ++d0)
#pragma unroll
            for (int r = 0; r < 16; ++r) stage[(qloc + crow(r, hi)) * STLD + 32 * d0 + r32] = o[d0][r] * scl[r];
    }
    asm volatile("s_waitcnt lgkmcnt(0)\n\ts_barrier" ::: "memory");
    if (map == 0) {
#pragma unroll
        for (int d0 = 0; d0 < 4; ++d0)
#pragma unroll
            for (int r = 0; r < 16; ++r) { LAS float* sp = stage + (qloc + crow(r, hi)) * STLD + 32 * d0 + r32; *sp = o[d0][r] * scl[r] - *sp; }
    }
    asm volatile("s_waitcnt lgkmcnt(0)\n\ts_barrier" ::: "memory");
    {
        const int row = tid >> 2, qu = tid & 3;
        const LAS float* sp = stage + row * STLD + qu * 32;
        f32x4 v[8]; float ss = 0.f;
#pragma unroll
        for (int i = 0; i < 8; ++i) { v[i] = *(const LAS f32x4*)(sp + 4 * i); ss += (v[i].x * v[i].x + v[i].y * v[i].y) + (v[i].z * v[i].z + v[i].w * v[i].w); }
        ss += __shfl_xor(ss, 1); ss += __shfl_xor(ss, 2);
        const float rn = rsqrtf(ss * (1.f / 128.f) + EPS) * (1.f - LAM_INIT);
        const float* hg = p.head_g + qu * 32;
#pragma unroll
        for (int i = 0; i < 4; ++i) { const u32x4 zw = zwv[i]; const f32x4 g0 = *(const f32x4*)(hg + 8 * i), g1 = *(const f32x4*)(hg + 8 * i + 4);
            const f32x4 z0 = {ep::lo16(zw.x), ep::hi16(zw.x), ep::lo16(zw.y), ep::hi16(zw.y)}, z1 = {ep::lo16(zw.z), ep::hi16(zw.z), ep::lo16(zw.w), ep::hi16(zw.w)};
            if (!dry) *(u32x4*)(Qb + go + 8 * i) = ep::pack8(v[2 * i] * rn * g0 * z0, v[2 * i + 1] * rn * g1 * z1); }
    }
    asm volatile("s_waitcnt lgkmcnt(0)\n\ts_barrier" ::: "memory");
#undef ATT_DMA
#undef ATT_TROW
}
__device__ __forceinline__ void attn_phase(Frame& F, const P& p, bool dry) {
    const float* sc = (const float*)(p.ws + WS_ROPE) + 2048;
    const float lam = sc[0], Mref = sc[1];
    const int per = (1024 + F.G - 1) / F.G;
    if (F.G == 256) {
        for (int i = 0; i < 4; ++i) { const int bh = (F.vcu >> 4) + 16 * i; attn_unit(bh >> 2, bh & 3, F.vcu & 15, p, F.lds + RING_OFF, lam, Mref, dry); }
    } else
    for (int i = 0; i < per; ++i) { const int u = F.vcu * per + i; if (u < 1024) attn_unit(u >> 6, (u >> 4) & 3, u & 15, p, F.lds + RING_OFF, lam, Mref, dry); }
}
}

namespace ml {
__device__ __forceinline__ void f8(const u32x4_t w, float* o) { o[0] = ep::lo16(w.x); o[1] = ep::hi16(w.x); o[2] = ep::lo16(w.y); o[3] = ep::hi16(w.y); o[4] = ep::lo16(w.z); o[5] = ep::hi16(w.z); o[6] = ep::lo16(w.w); o[7] = ep::hi16(w.w); }
__device__ __forceinline__ void finish_phase(Frame& F, const P& p) {
    const int gw = F.vcu * NWAVES + F.wave, NGW = F.G * NWAVES; const int c0 = F.lane * 8;
    float cw0[8], cw1[8], cw2[8], cbv[8], hg[8], sk[8];
#pragma unroll
    for (int i = 0; i < 8; ++i) { cw0[i] = p.conv_w[c0 + i]; cw1[i] = p.conv_w[512 + c0 + i]; cw2[i] = p.conv_w[1024 + c0 + i]; cbv[i] = p.conv_b[c0 + i]; hg[i] = p.ml_head_g[c0 + i]; sk[i] = p.ml_skip[c0 + i]; }
    const bf16_t* HF = (const bf16_t*)(p.ws + WS_HF); const bf16_t* HB = (const bf16_t*)(p.ws + WS_HB); const bf16_t* XM = (const bf16_t*)(p.ws + WS_XM);
    const bf16_t* OB = (const bf16_t*)(p.ws + WS_OB); const bf16_t* ZB = (const bf16_t*)(p.ws + WS_ZB); bf16_t* YB = (bf16_t*)(p.ws + WS_YB);
    for (int row = gw; row < R; row += NGW) {
        const size_t o = (size_t)row * 512 + c0; const int t = row & (SEQ - 1);
        float hf[8], hb[8], x0[8], x1[8], x2[8], ob[8], zb[8];
        f8(*(const u32x4_t*)(HF + o), hf); f8(*(const u32x4_t*)(HB + o), hb); f8(*(const u32x4_t*)(XM + o), x1);
        f8(*(const u32x4_t*)(OB + o), ob); f8(*(const u32x4_t*)(ZB + o), zb);
        if (t > 0) f8(*(const u32x4_t*)(XM + o - 512), x0); else {
#pragma unroll
            for (int i = 0; i < 8; ++i) x0[i] = 0.f; }
        if (t < SEQ - 1) f8(*(const u32x4_t*)(XM + o + 512), x2); else {
#pragma unroll
            for (int i = 0; i < 8; ++i) x2[i] = 0.f; }
        float ss = 0.f;
#pragma unroll
        for (int i = 0; i < 8; ++i) { hf[i] += hb[i]; ss += hf[i] * hf[i]; }
        ss += __shfl_xor(ss, 1); ss += __shfl_xor(ss, 2); ss += __shfl_xor(ss, 4); ss += __shfl_xor(ss, 8);
        const float rn = rsqrtf(ss * (1.f / 128.f) + EPS);
        float y[8];
#pragma unroll
        for (int i = 0; i < 8; ++i) { const float a = cbv[i] + cw0[i] * x0[i] + cw1[i] * x1[i] + cw2[i] * x2[i]; const float xcv = a * ep::fsig(a);
            y[i] = (ob[i] * (hf[i] * rn * hg[i]) + sk[i] * xcv) * zb[i]; }
        u32x4_t w; w.x = pg8::cvt_pk_bf16(y[0], y[1]); w.y = pg8::cvt_pk_bf16(y[2], y[3]); w.z = pg8::cvt_pk_bf16(y[4], y[5]); w.w = pg8::cvt_pk_bf16(y[6], y[7]);
        *(u32x4_t*)(YB + o) = w;
    }
}
}

namespace mlf {
using bf16x8 = __attribute__((ext_vector_type(8))) short;
using s16x4 = __attribute__((ext_vector_type(4))) short;
using f32x16 = __attribute__((ext_vector_type(16))) float;
typedef short v4i16_t __attribute__((ext_vector_type(4)));
typedef LAS const char* lds_cptr;
typedef unsigned u32x2_t __attribute__((ext_vector_type(2)));
#define MLF_MFMA(a, b, c) __builtin_amdgcn_mfma_f32_32x32x16_bf16(a, b, c, 0, 0, 0)
__device__ __forceinline__ s16x4 vtr(lds_cptr p) { return __builtin_bit_cast(s16x4, __builtin_amdgcn_ds_read_tr16_b64_v4i16((LAS v4i16_t*)p)); }
__device__ __forceinline__ bf16x8 trfrag(lds_cptr p, int second) { const s16x4 lo = vtr(p), hh = vtr(p + second); return (bf16x8){lo[0], lo[1], lo[2], lo[3], hh[0], hh[1], hh[2], hh[3]}; }
__device__ __forceinline__ int crow(int r, int hi) { return (r & 3) + 8 * (r >> 2) + 4 * hi; }

constexpr int PL_WQ = 0, PL_WK = 32768, PL_CV = 65536, PL_XC = 67584;
__device__ __forceinline__ void prep_load_head(const P& p, LAS unsigned char* shm, int h) {
    const int tid = threadIdx.x;
    const bf16_t* WQT = (const bf16_t*)(p.ws + WS_MWQ) + (size_t)h * 16384;
#pragma unroll
    for (int i = 0; i < 8; ++i) { const int idx = tid + 512 * i, mat = idx >> 11, ch = idx & 2047, e = ch >> 4, c = ch & 15;
        *(LAS u32x4_t*)(shm + mat * 32768 + e * 256 + ((c ^ (e & 15)) << 4)) = *(const u32x4_t*)(WQT + mat * 65536 + e * 128 + c * 8); }
    { const int a = tid >> 7, d = tid & 127; ((LAS float*)(shm + PL_CV))[tid] = a < 3 ? p.conv_w[a * 512 + h * 128 + d] : p.conv_b[h * 128 + d]; }
}
struct PrepX { u32x4_t x0[4], x1[4], x2[4]; float mp, mn; };
__device__ __forceinline__ void prep_loadx(const P& p, int c, int h, PrepX& X) {
    const int tid = threadIdx.x, lane = tid & 63, r32 = lane & 31, hi = lane >> 5; const int wid = __builtin_amdgcn_readfirstlane(tid >> 6);
    const int tq = wid & 3, eh = wid >> 2;
    const bool lat = c < 256; const int row0 = lat ? c * 128 : R + (c - 256) * 128;
    const int row = row0 + 32 * tq + r32; const int L = lat ? SEQ : CTX; const int t = (lat ? row : row - R) & (L - 1);
    const char* XM = (const char*)(p.ws + WS_XM) + (unsigned)(row * 1024 + h * 256 + 16 * hi);
    X.mp = t > 0 ? 1.f : 0.f; X.mn = t < L - 1 ? 1.f : 0.f; const int op = t > 0 ? -1024 : 0, on = t < L - 1 ? 1024 : 0;
#pragma unroll
    for (int k4 = 0; k4 < 4; ++k4) { const int ks = 4 * eh + k4; X.x1[k4] = *(const u32x4_t*)(XM + 32 * ks); X.x0[k4] = *(const u32x4_t*)(XM + op + 32 * ks); X.x2[k4] = *(const u32x4_t*)(XM + on + 32 * ks); }
}
__device__ __forceinline__ void prep_unit(const P& p, LAS unsigned char* shm, int c, int h, PrepX& X, int cn, int hn) {
    const int tid = threadIdx.x, lane = tid & 63, r32 = lane & 31, hi = lane >> 5; const int wid = __builtin_amdgcn_readfirstlane(tid >> 6);
    const int tq = wid & 3, eh = wid >> 2;
    const bool lat = c < 256; const int row0 = lat ? c * 128 : R + (c - 256) * 128;
    const int row = row0 + 32 * tq + r32;
    const LAS float* cv = (const LAS float*)(shm + PL_CV) + 8 * hi;
    const lds_cptr wq = (lds_cptr)shm + PL_WQ + (64 * eh + r32) * 256, wk = (lds_cptr)shm + PL_WK + (64 * eh + r32) * 256;
    f32x16 aq[2], ak[2]; aq[0] = f32x16{}; aq[1] = f32x16{}; ak[0] = f32x16{}; ak[1] = f32x16{};
    LAS unsigned char* xcl = shm + PL_XC + tq * 8192 + lane * 16;
#pragma unroll
    for (int k4 = 0; k4 < 4; ++k4) { const int ks = 4 * eh + k4;
        float x0[8], x1[8], x2[8], w0[8], w1[8], w2[8], bb[8];
        ml::f8(X.x0[k4], x0); ml::f8(X.x1[k4], x1); ml::f8(X.x2[k4], x2);
#pragma unroll
        for (int q = 0; q < 2; ++q) { const f32x4 a = *(const LAS f32x4*)(cv + 16 * ks + 4 * q), b = *(const LAS f32x4*)(cv + 128 + 16 * ks + 4 * q), cc = *(const LAS f32x4*)(cv + 256 + 16 * ks + 4 * q), d = *(const LAS f32x4*)(cv + 384 + 16 * ks + 4 * q);
#pragma unroll
            for (int i = 0; i < 4; ++i) { w0[4 * q + i] = a[i]; w1[4 * q + i] = b[i]; w2[4 * q + i] = cc[i]; bb[4 * q + i] = d[i]; } }
        float y[8];
#pragma unroll
        for (int i = 0; i < 8; ++i) { const float a = bb[i] + w0[i] * (x0[i] * X.mp) + w1[i] * x1[i] + w2[i] * (x2[i] * X.mn); y[i] = a * ep::fsig(a); }
        u32x4_t xw; xw.x = pg8::cvt_pk_bf16(y[0], y[1]); xw.y = pg8::cvt_pk_bf16(y[2], y[3]); xw.z = pg8::cvt_pk_bf16(y[4], y[5]); xw.w = pg8::cvt_pk_bf16(y[6], y[7]);
        *(LAS u32x4_t*)(xcl + ks * 1024) = xw;
    }
    asm volatile("s_waitcnt lgkmcnt(0)\n\ts_barrier" ::: "memory");
    if (cn >= 0) prep_loadx(p, cn, hn, X);
#pragma unroll
    for (int ks = 0; ks < 8; ++ks) {
        const bf16x8 xf = *(const LAS bf16x8*)(xcl + ks * 1024);
        const int sw = ((2 * ks + hi) ^ (r32 & 15)) << 4;
#pragma unroll
        for (int nb = 0; nb < 2; ++nb) {
            const bf16x8 wqf = *(const LAS bf16x8*)(wq + nb * 8192 + sw), wkf = *(const LAS bf16x8*)(wk + nb * 8192 + sw);
            aq[nb] = MLF_MFMA(wqf, xf, aq[nb]); ak[nb] = MLF_MFMA(wkf, xf, ak[nb]);
        }
    }
    char* MQ = (char*)(p.ws + WS_MQ) + (unsigned)(row * 1024 + h * 256 + 128 * eh + 8 * hi); char* MK = MQ + (WS_MK - WS_MQ);
#pragma unroll
    for (int nb = 0; nb < 2; ++nb)
#pragma unroll
        for (int g = 0; g < 4; ++g) {
            u32x2_t a, b; a.x = att::cvtpk_s(aq[nb][4 * g], aq[nb][4 * g + 1]); a.y = att::cvtpk_s(aq[nb][4 * g + 2], aq[nb][4 * g + 3]);
            b.x = att::cvtpk_s(ak[nb][4 * g], ak[nb][4 * g + 1]); b.y = att::cvtpk_s(ak[nb][4 * g + 2], ak[nb][4 * g + 3]);
            *(u32x2_t*)(MQ + 64 * nb + 16 * g) = a; *(u32x2_t*)(MK + 64 * nb + 16 * g) = b;
        }
    asm volatile("s_waitcnt lgkmcnt(0)\n\ts_barrier" ::: "memory");
}
__device__ __forceinline__ void prep_phase(Frame& F, const P& p) {
    int hl = -1; PrepX X;
    if (F.vcu < 1152) prep_loadx(p, F.vcu >> 2, F.vcu & 3, X);
    for (int u = F.vcu; u < 1152; u += F.G) { const int h = u & 3;
        if (h != hl) { __syncthreads(); prep_load_head(p, F.lds + RING_OFF, h); __syncthreads(); hl = h; }
        const int un = u + F.G;
        prep_unit(p, F.lds + RING_OFF, u >> 2, h, X, un < 1152 ? (un >> 2) : -1, un & 3); }
    __syncthreads();
}

constexpr int L_KT = 0  , L_VP = 65536, L_CB = 90112, L_GT = 106496  , L_NV = 112128;
constexpr int GT_WROW = 0, GT_MU2 = 512, GT_DEC = 1024, GT_CLAMP = 1536, GT_WGT = 2048, GT_CARRY = 2560, GT_STRIDE = 2816;
constexpr float LOG2E = 1.4426950408889634f;
__device__ __forceinline__ void glds16(const void* gsrc, unsigned lds_dst) { unsigned keep;
    asm volatile("s_mov_b32 %0, m0\n\ts_mov_b32 m0, %2\n\ts_nop 0\n\tglobal_load_lds_dwordx4 %1, off\n\ts_mov_b32 m0, %0" : "=&s"(keep) : "v"(gsrc), "s"(lds_dst) : "memory"); }
#define MLF_GL16(dst, ptr) asm volatile("global_load_dwordx4 %0, %1, off" : "=v"(dst) : "v"(ptr) : "memory")

#ifndef TPROBE
#define TPROBE 0
#endif
#define TP_ON(k) if (TPROBE == (k)) tp_t0 = __builtin_amdgcn_s_memrealtime()
#define TP_OFF(k) if (TPROBE == (k)) tp_acc += __builtin_amdgcn_s_memrealtime() - tp_t0
template <bool NOMEM> __device__ __forceinline__ void chain_unit(const P& p, LAS unsigned char* shm, int u) {
    unsigned long long tp_t0 = 0, tp_acc = 0; TP_ON(1);
    const int tid = threadIdx.x, lane = tid & 63, r32 = lane & 31, hi = lane >> 5; const int wid = __builtin_amdgcn_readfirstlane(tid >> 6);
    const int vh = u & 1, dir = (u >> 1) & 1, h = (u >> 2) & 3, b = u >> 4;
    const bf16_t* MQ = (const bf16_t*)(p.ws + WS_MQ) + h * 128; const bf16_t* MK = (const bf16_t*)(p.ws + WS_MK) + h * 128; const bf16_t* VM = (const bf16_t*)(p.ws + WS_VM) + h * 128 + 64 * vh;
    const float* GG = (const float*)(p.ws + WS_GATES) + dir * 8 + h;
    bf16_t* HO = (bf16_t*)(p.ws + (dir ? WS_HB : WS_HF)) + h * 128 + 64 * vh;
    const unsigned lds0 = (unsigned)(uintptr_t)shm; const lds_cptr shm3 = (lds_cptr)shm;
    const int trofs = ((lane >> 4) & 1) * 32 + (lane & 3) * 8;
    const int tr_perm = trofs + (4 * hi + ((lane & 15) >> 2)) * 64;
    const int tr_nat = trofs + (8 * hi + ((lane & 15) >> 2)) * 64;
    const int krow = (r32 >> 4) * 1024 + (r32 & 15) * 64 + 16 * hi;
    const int sgn = dir ? -1 : 1;
#define MLF_RSTART(j) ((j) < 2 ? R + b * CTX + (dir ? (CTX - 1 - 128 * (j)) : (128 * (j))) : b * SEQ + (dir ? (SEQ - 1 - 128 * ((j) - 2)) : (128 * ((j) - 2))))
#define MLF_AT(base, rowi, colb) ((const char*)(base) + (unsigned)((rowi) * 1024 + (colb)))
#define MLF_DMA_K(j) do { if (NOMEM) break; const int rs_ = MLF_RSTART(j); \
        _Pragma("unroll") for (int i_ = 0; i_ < 4; ++i_) { const int pc_ = 4 * wid + i_, eb_ = pc_ >> 3, sg_ = pc_ & 7; \
            glds16(MLF_AT(MK, rs_ + sgn * (16 * sg_ + (lane >> 2)), 64 * eb_ + (lane & 3) * 16), (unsigned)__builtin_amdgcn_readfirstlane(lds0 + L_KT + ((j) & 1) * 32768 + pc_ * 1024)); } } while (0)
#define MLF_GLOAD(j) do { if (NOMEM) break; const int rs_ = MLF_RSTART(j); \
        const float* g0_ = (const float*)((const char*)GG + (unsigned)((rs_ + sgn * (2 * lane)) * 64)); const float* g1_ = (const float*)((const char*)GG + (unsigned)((rs_ + sgn * (2 * lane + 1)) * 64)); \
        graw[0] = g0_[0]; graw[1] = g0_[4]; graw[2] = g1_[0]; graw[3] = g1_[4]; } while (0)
#define MLF_GATES(j) do { LAS float* gt_ = (LAS float*)(shm + L_GT + ((j) & 1) * GT_STRIDE); \
        const float i0_ = graw[0], f0_ = graw[1], i1_ = graw[2], f1_ = graw[3]; \
        float cs_ = f0_ + f1_; _Pragma("unroll") for (int o_ = 1; o_ < 64; o_ <<= 1) { const float t_ = __shfl_up(cs_, o_); if (lane >= o_) cs_ += t_; } \
        const float c1_ = cs_, c0_ = cs_ - f1_; const float a0_ = i0_ - c0_, a1_ = i1_ - c1_; \
        float mx_ = fmaxf(a0_, a1_); _Pragma("unroll") for (int o_ = 1; o_ < 64; o_ <<= 1) { const float t_ = __shfl_up(mx_, o_); if (lane >= o_) mx_ = fmaxf(mx_, t_); } \
        float pm_ = __shfl_up(mx_, 1); if (lane == 0) pm_ = -3.0e38f; \
        const float mu0_ = fmaxf(mst, fmaxf(pm_, a0_)), mu1_ = fmaxf(mst, mx_); \
        const float muend_ = __shfl(mu1_, 63), ftot_ = __shfl(c1_, 63); \
        typedef float f2_ __attribute__((ext_vector_type(2))); \
        ((LAS f2_*)(gt_ + GT_WROW / 4))[lane] = (f2_){__expf(muend_ - mu0_), __expf(muend_ - mu1_)}; \
        ((LAS f2_*)(gt_ + GT_DEC / 4))[lane] = (f2_){__expf(mst - mu0_), __expf(mst - mu1_)}; ((LAS f2_*)(gt_ + GT_CLAMP / 4))[lane] = (f2_){__expf(-(c0_ + mu0_)), __expf(-(c1_ + mu1_))}; \
        ((LAS f2_*)(gt_ + GT_WGT / 4))[lane] = (f2_){__expf(a0_ - muend_), __expf(a1_ - muend_)}; if (lane == 0) gt_[GT_CARRY / 4] = __expf(mst - muend_); \
        mst = ftot_ + muend_; } while (0)
    float mst = 0.f;
    __syncthreads();
    for (int i = tid; i < 16384 / 16; i += 512) *(LAS u32x4_t*)(shm + L_CB + i * 16) = (u32x4_t){0u, 0u, 0u, 0u};
    for (int i = tid; i < 8192 / 16; i += 512) *(LAS u32x4_t*)(shm + L_VP + 16384 + i * 16) = (u32x4_t){0u, 0u, 0u, 0u};
    if (tid < 128) ((LAS float*)(shm + L_NV))[tid] = 0.f;
    float graw[4] = {0.f, 0.f, 0.f, 0.f};
    if (wid == 0) { MLF_GLOAD(0); MLF_GATES(0); MLF_GLOAD(1); }
    MLF_DMA_K(0); MLF_DMA_K(1);
#define MLF_BAR_A() asm volatile("s_waitcnt lgkmcnt(0)\n\ts_barrier" ::: "memory")
#define MLF_BAR_B(N) asm volatile("s_waitcnt vmcnt(" #N ") lgkmcnt(0)\n\ts_barrier" ::: "memory")
    MLF_BAR_B(0);
    if (wid < 4) {
        const int tq = wid;
        f32x16 S[4]; S[0] = f32x16{}; S[1] = f32x16{}; S[2] = f32x16{}; S[3] = f32x16{};
#define PWSET(st, kk, k, val) S[2 + ((st) >> 1)][((st) & 1) * 8 + (kk) * 4 + (k)] = __uint_as_float(val)
#define PWGET(st, kk) __builtin_bit_cast(bf16x8, (f32x4){S[2 + ((st) >> 1)][((st) & 1) * 8 + (kk) * 4], S[2 + ((st) >> 1)][((st) & 1) * 8 + (kk) * 4 + 1], S[2 + ((st) >> 1)][((st) & 1) * 8 + (kk) * 4 + 2], S[2 + ((st) >> 1)][((st) & 1) * 8 + (kk) * 4 + 3]})
        u32x4_t qf[8];
#pragma unroll
        for (int ks = 0; ks < 8; ++ks) qf[ks] = (u32x4_t){0u, 0u, 0u, 0u};
        for (int j = 0; j < 18; ++j) {
            int rs = MLF_RSTART(j); asm volatile("" : "+s"(rs));
            const LAS float* gt = (const LAS float*)(shm + L_GT + (j & 1) * GT_STRIDE);
            float dq = 0.f;
            TP_ON(2);
            if (j >= 2) {
                const float wrow = gt[GT_WROW / 4 + 32 * tq + r32];
                const lds_cptr kt = shm3 + L_KT + (j & 1) * 32768 + krow;
                const lds_cptr cb = shm3 + L_CB + tr_nat;
                s16x4 tc0[16], tc1[16];
#pragma unroll
                for (int ks = 0; ks < 8; ++ks) { tc0[2 * ks] = vtr(cb + ks * 1024); tc0[2 * ks + 1] = vtr(cb + ks * 1024 + 256); }
                bf16x8 kf[8];
#pragma unroll
                for (int ks = 0; ks < 8; ++ks) kf[ks] = *(const LAS bf16x8*)(kt + (ks >> 1) * 8192 + (ks & 1) * 32);
                __builtin_amdgcn_sched_barrier(0);
#pragma unroll
                for (int st = 0; st < 4; ++st) if (st <= tq) {
                    f32x16 X = f32x16{};
#pragma unroll
                    for (int ks = 0; ks < 8; ++ks) X = MLF_MFMA(kf[ks], __builtin_bit_cast(bf16x8, qf[ks]), X);
                    if (st < tq) {
#pragma unroll
                        for (int ks = 0; ks < 8; ++ks) kf[ks] = *(const LAS bf16x8*)(kt + (st + 1) * 2048 + (ks >> 1) * 8192 + (ks & 1) * 32); }
                    X = X * wrow;
                    if (st == tq) {
#pragma unroll
                        for (int r = 0; r < 16; ++r) if (crow(r, hi) > r32) X[r] = 0.f; }
#pragma unroll
                    for (int k = 0; k < 4; ++k) { PWSET(st, 0, k, att::cvtpk_s(X[2 * k], X[2 * k + 1])); PWSET(st, 1, k, att::cvtpk_s(X[8 + 2 * k], X[9 + 2 * k])); }
                }
                const float decs = gt[GT_DEC / 4 + 32 * tq + r32];
#pragma unroll
                for (int ks = 0; ks < 8; ++ks) { tc1[2 * ks] = vtr(cb + 8192 + ks * 1024); tc1[2 * ks + 1] = vtr(cb + 8192 + ks * 1024 + 256); }
                __builtin_amdgcn_sched_barrier(0);
                { f32x16 a = f32x16{};
#pragma unroll
                  for (int ks = 0; ks < 8; ++ks) { const s16x4 lo = tc0[2 * ks], hh = tc0[2 * ks + 1]; a = MLF_MFMA(((bf16x8){lo[0], lo[1], lo[2], lo[3], hh[0], hh[1], hh[2], hh[3]}), __builtin_bit_cast(bf16x8, qf[ks]), a); }
                  S[0] = a * decs; }
                { f32x16 a = f32x16{};
#pragma unroll
                  for (int ks = 0; ks < 8; ++ks) { const s16x4 lo = tc1[2 * ks], hh = tc1[2 * ks + 1]; a = MLF_MFMA(((bf16x8){lo[0], lo[1], lo[2], lo[3], hh[0], hh[1], hh[2], hh[3]}), __builtin_bit_cast(bf16x8, qf[ks]), a); }
                  S[1] = a * decs; }
                const LAS float* nv = (const LAS float*)(shm + L_NV);
                float qn = 0.f;
#pragma unroll
                for (int ks = 0; ks < 8; ++ks) { float qv[8]; ml::f8(qf[ks], qv); const f32x4 n0 = *(const LAS f32x4*)(nv + 16 * ks + 8 * hi), n1 = *(const LAS f32x4*)(nv + 16 * ks + 8 * hi + 4);
                    qn += (qv[0] * n0[0] + qv[1] * n0[1]) + (qv[2] * n0[2] + qv[3] * n0[3]) + (qv[4] * n1[0] + qv[5] * n1[1]) + (qv[6] * n1[2] + qv[7] * n1[3]); }
                { auto rr = __builtin_amdgcn_permlane32_swap(__float_as_uint(qn), __float_as_uint(qn), false, false); qn = __uint_as_float(rr[0]) + __uint_as_float(rr[1]); }
                dq = decs * qn;
            }
            if (wid == 0 && j + 1 < 18) MLF_GATES(j + 1);
            TP_OFF(2); TP_ON(3);
            MLF_BAR_A();
            TP_OFF(3); TP_ON(4);
            if (!NOMEM && j + 1 >= 2 && j + 1 < 18) { const char* qp = MLF_AT(MQ, MLF_RSTART(j + 1) + sgn * (32 * tq + r32), 16 * hi);
#pragma unroll
                for (int ks = 0; ks < 8; ++ks) qf[ks] = *(const u32x4_t*)(qp + 32 * ks); }
            if (wid == 0 && j + 2 < 18) MLF_GLOAD(j + 2);
            if (j >= 2) {
                const lds_cptr vv = shm3 + L_VP + tr_perm;
                char* hop = (char*)HO + (unsigned)((rs + sgn * (32 * tq + r32)) * 1024 + 8 * hi);
                f32x16 accd = f32x16{};
#pragma unroll
                for (int sp = 0; sp < 2; ++sp) if (2 * sp <= tq) {
                    s16x4 tv[24];
#pragma unroll
                    for (int s2 = 0; s2 < 2; ++s2) if (2 * sp + s2 <= tq)
#pragma unroll
                        for (int kk = 0; kk < 2; ++kk)
#pragma unroll
                            for (int db = 0; db < 3; ++db) { const int sg = 2 * (2 * sp + s2) + kk, i = ((s2 * 2 + kk) * 3 + db) * 2; tv[i] = vtr(vv + db * 8192 + sg * 1024); tv[i + 1] = vtr(vv + db * 8192 + sg * 1024 + 512); }
                    __builtin_amdgcn_sched_barrier(0);
#pragma unroll
                    for (int s2 = 0; s2 < 2; ++s2) if (2 * sp + s2 <= tq)
#pragma unroll
                        for (int kk = 0; kk < 2; ++kk) { const bf16x8 pf = PWGET(2 * sp + s2, kk);
#pragma unroll
                            for (int db = 0; db < 3; ++db) { const int i = ((s2 * 2 + kk) * 3 + db) * 2; const bf16x8 vf8 = (bf16x8){tv[i][0], tv[i][1], tv[i][2], tv[i][3], tv[i + 1][0], tv[i + 1][1], tv[i + 1][2], tv[i + 1][3]};
                                if (db == 2) accd = MLF_MFMA(vf8, pf, accd); else S[db] = MLF_MFMA(vf8, pf, S[db]); } }
                    __builtin_amdgcn_sched_barrier(0);
                }
                float dsum = hi == 0 ? accd[0] : 0.f;
                { auto rr = __builtin_amdgcn_permlane32_swap(__float_as_uint(dsum), __float_as_uint(dsum), false, false); dsum = __uint_as_float(rr[0]) + __uint_as_float(rr[1]); }
                const float hinv = __builtin_amdgcn_rcpf(fmaxf(fabsf(dsum + dq), gt[GT_CLAMP / 4 + 32 * tq + r32]));
#pragma unroll
                for (int db = 0; db < 2; ++db) {
                    const f32x16 acc = S[db] * hinv;
#pragma unroll
                    for (int g = 0; g < 4; ++g) { u32x2_t w; w.x = att::cvtpk_s(acc[4 * g], acc[4 * g + 1]); w.y = att::cvtpk_s(acc[4 * g + 2], acc[4 * g + 3]); if (!NOMEM) *(u32x2_t*)(hop + 64 * db + 16 * g) = w; else asm volatile("" :: "v"(w)); }
                }
            }
            TP_OFF(4); TP_ON(5);
            MLF_BAR_B(8);
            TP_OFF(5);
            if (j + 2 < 18) MLF_DMA_K(j + 2);
        }
    } else {
        const int et = wid - 4;
        f32x16 C[3]; C[0] = f32x16{}; C[1] = f32x16{}; C[2] = f32x16{};
        const int t4 = tid - 256; const int vs = t4 >> 1, vdb = t4 & 1;
        u32x4_t vf[4];
        if (!NOMEM) { const char* vp = MLF_AT(VM, MLF_RSTART(0) + sgn * vs, 64 * vdb);
#pragma unroll
          for (int c = 0; c < 4; ++c) vf[c] = *(const u32x4_t*)(vp + 16 * c); }
        else { vf[0] = vf[1] = vf[2] = vf[3] = (u32x4_t){0u, 0u, 0u, 0u}; }
        for (int j = 0; j < 18; ++j) {
            const LAS float* gt = (const LAS float*)(shm + L_GT + (j & 1) * GT_STRIDE);
            TP_ON(6);
            { const float wg = gt[GT_WGT / 4 + vs];
              LAS unsigned char* dst = shm + L_VP + vdb * 8192 + (vs >> 4) * 1024 + (vs & 15) * 64;
#pragma unroll
              for (int c = 0; c < 4; ++c) { float v[8]; ml::f8(vf[c], v);
                  u32x4_t w; w.x = pg8::cvt_pk_bf16(v[0] * wg, v[1] * wg); w.y = pg8::cvt_pk_bf16(v[2] * wg, v[3] * wg); w.z = pg8::cvt_pk_bf16(v[4] * wg, v[5] * wg); w.w = pg8::cvt_pk_bf16(v[6] * wg, v[7] * wg);
                  *(LAS u32x4_t*)(dst + 16 * c) = w; }
              if (vdb == 0) *(LAS bf16_t*)(shm + L_VP + 16384 + (vs >> 4) * 1024 + (vs & 15) * 64) = f2bf(wg); }
            TP_OFF(6); TP_ON(8);
            MLF_BAR_A();
            TP_OFF(8); TP_ON(7);
            if (!NOMEM && j + 1 < 18) { const char* vp = MLF_AT(VM, MLF_RSTART(j + 1) + sgn * vs, 64 * vdb);
#pragma unroll
                for (int c = 0; c < 4; ++c) vf[c] = *(const u32x4_t*)(vp + 16 * c); }
            const float carry = gt[GT_CARRY / 4];
            const lds_cptr ka = shm3 + L_KT + (j & 1) * 32768 + et * 8192 + tr_perm; const lds_cptr vb = shm3 + L_VP + tr_perm;
#pragma unroll
            for (int db = 0; db < 3; ++db)
#pragma unroll
                for (int r = 0; r < 16; ++r) C[db][r] *= carry;
#pragma unroll
            for (int half = 0; half < 2; ++half) {
                s16x4 ta[8], tb[24];
#pragma unroll
                for (int k4 = 0; k4 < 4; ++k4) { const int ks = 4 * half + k4; ta[2 * k4] = vtr(ka + ks * 1024); ta[2 * k4 + 1] = vtr(ka + ks * 1024 + 512);
#pragma unroll
                    for (int db = 0; db < 3; ++db) { tb[6 * k4 + 2 * db] = vtr(vb + db * 8192 + ks * 1024); tb[6 * k4 + 2 * db + 1] = vtr(vb + db * 8192 + ks * 1024 + 512); } }
                __builtin_amdgcn_sched_barrier(0);
#pragma unroll
                for (int k4 = 0; k4 < 4; ++k4) { const bf16x8 af = (bf16x8){ta[2 * k4][0], ta[2 * k4][1], ta[2 * k4][2], ta[2 * k4][3], ta[2 * k4 + 1][0], ta[2 * k4 + 1][1], ta[2 * k4 + 1][2], ta[2 * k4 + 1][3]};
#pragma unroll
                    for (int db = 0; db < 3; ++db) { const s16x4 lo = tb[6 * k4 + 2 * db], hh = tb[6 * k4 + 2 * db + 1];
                        C[db] = MLF_MFMA(((bf16x8){lo[0], lo[1], lo[2], lo[3], hh[0], hh[1], hh[2], hh[3]}), af, C[db]); } }
                __builtin_amdgcn_sched_barrier(0);
            }
            { const int e = 32 * et + r32; LAS unsigned char* cbn = shm + L_CB + (e >> 4) * 1024 + (e & 15) * 64 + 8 * hi;
#pragma unroll
              for (int db = 0; db < 2; ++db)
#pragma unroll
                  for (int g = 0; g < 4; ++g) { u32x2_t w; w.x = att::cvtpk_s(C[db][4 * g], C[db][4 * g + 1]); w.y = att::cvtpk_s(C[db][4 * g + 2], C[db][4 * g + 3]); *(LAS u32x2_t*)(cbn + db * 8192 + 16 * g) = w; }
              if (hi == 0) ((LAS float*)(shm + L_NV))[e] = C[2][0]; }
            TP_OFF(7); TP_ON(9);
            MLF_BAR_B(4);
            TP_OFF(9);
            if (j + 2 < 18) MLF_DMA_K(j + 2);
        }
    }
    asm volatile("s_waitcnt vmcnt(0) lgkmcnt(0)\n\ts_barrier" ::: "memory");
    TP_OFF(1);
    if (TPROBE) { const unsigned long long s0 = __builtin_amdgcn_s_memrealtime(); while (__builtin_amdgcn_s_memrealtime() - s0 < tp_acc) __builtin_amdgcn_s_sleep(1); asm volatile("s_barrier" ::: "memory"); }
#undef MLF_BAR_A
#undef MLF_BAR_B
#undef PWSET
#undef PWGET
#undef MLF_DMA_K
#undef MLF_AT
#undef MLF_GATES
#undef MLF_GLOAD
#undef MLF_RSTART
}
__device__ __forceinline__ void chain_phase(Frame& F, const P& p) {
#if (PROBE_DUP >> 10) & 1
    for (int u = F.vcu; u < 256; u += F.G) chain_unit<true>(p, F.lds + RING_OFF, u);
#endif
    for (int u = F.vcu; u < 256; u += F.G) chain_unit<false>(p, F.lds + RING_OFF, u); }
}

#ifndef PROBE_DUP
#define PROBE_DUP 0
#endif
__device__ __forceinline__ int reps_of(int k) { int r = ((PROBE_DUP >> k) & 1) ? 2 : 1; if (PROBE_DUP) asm volatile("" : "+s"(r)); return r; }
#define REPS(k) reps_of(k)
struct Args { P p; int ph_lo, ph_hi, li, pad; };
__global__ void __launch_bounds__(NWAVES * 64, 2) skel_fwd(Args args) {
    extern __shared__ __attribute__((aligned(16))) unsigned char lds[];
    Frame F;
    F.lds = (LAS unsigned char*)lds;
    F.MISC = (volatile LAS unsigned*)(F.lds + MISC_OFF);
    F.tid = threadIdx.x; F.lane = F.tid & 63; F.wave = __builtin_amdgcn_readfirstlane(F.tid >> 6);
    F.G = gridDim.x; { const int bx = blockIdx.x; F.vcu = (F.G % 8 == 0) ? (bx % 8) * (F.G / 8) + bx / 8 : bx; }
    const P& p = args.p;
    F.ctl = (gu32*)(p.ws + WS_CTL);
    for (int u = F.tid; u < (LDS_BYTES - LDSCTL_OFF) / 4; u += NWAVES * 64) ((LAS unsigned*)(F.lds + LDSCTL_OFF))[u] = 0u;
    __syncthreads();
    const int lo = args.ph_lo, hi = args.ph_hi;
    XcdBarrier bar = xcd_barrier_post((unsigned*)(F.ctl + CW_BAR) + args.li * XCD_BAR_WORDS, F.MISC + 8);
#define IN(k) (lo <= (k) && (k) < hi)
#define BOTH(k) (IN(k) && (k) + 1 < hi)
#define GRID_BAR() xcd_barrier(bar)
    if (IN(0)) { for (int rep = 0; rep < REPS(0); ++rep) p0_prologue(F, p); if (BOTH(0)) GRID_BAR(); }
    if (IN(1)) { for (int rep = 0; rep < REPS(1); ++rep) { p1_hrows(F, p); p_transposes(F, p); } if (BOTH(1)) GRID_BAR(); }
#if (PROBE_DUP >> 9) & 1
    for (int rep = 0; rep < 16; ++rep) GRID_BAR();
#endif
    if (IN(2)) {
        pg8::Gemm g{(const bf16_t*)(p.ws + WS_H), (const bf16_t*)(p.ws + WS_WTIN), nullptr, nullptr, 1024};
        ep::SchedIn S; S.init(F.G, (int)blockIdx.x);
        ep::EpiIn E{p.ws, p.q_g, p.k_g, p.b_if};
        pg8::gemm_phase<ep::EpiIn, ep::SchedIn, true, true>(F.lds + RING_OFF, g, S, E);
        if (BOTH(2)) GRID_BAR();
    }
    if (IN(3)) { for (int rep = 0; rep < REPS(3); ++rep) att::attn_phase(F, p, rep + 1 < REPS(3)); for (int rep = 0; rep < REPS(8); ++rep) mlf::prep_phase(F, p); if (BOTH(3)) GRID_BAR(); }
    if (IN(4)) { for (int rep = 0; rep < REPS(4); ++rep) mlf::chain_phase(F, p); if (BOTH(4)) GRID_BAR(); }
    if (IN(5)) { for (int rep = 0; rep < REPS(5); ++rep) ml::finish_phase(F, p); if (BOTH(5)) GRID_BAR(); }
    if (IN(6)) {
        pg8::Gemm g{(const bf16_t*)(p.ws + WS_Q), (const bf16_t*)(p.ws + WS_WTOA), (const bf16_t*)(p.ws + WS_YB), (const bf16_t*)(p.ws + WS_WTOB), 512};
        ep::SchedMerge S; S.init(F.G, (int)blockIdx.x);
        ep::EpiMerge E{(bf16_t*)(p.ws + WS_GA), (bf16_t*)(p.ws + WS_GB)};
        pg8::gemm_phase<ep::EpiMerge, ep::SchedMerge, true, true>(F.lds + RING_OFF, g, S, E);
        if (BOTH(6)) GRID_BAR();
    }
    if (IN(7)) {
        pg8::Gemm g{(const bf16_t*)(p.ws + WS_GB), (const bf16_t*)(p.ws + WS_WTO), nullptr, nullptr, 1024};
        ep::SchedOut S; S.init(F.G, (int)blockIdx.x);
        ep::EpiOut E{p.x, (const float*)(p.ws + WS_MOD), p.out};
        pg8::gemm_phase<ep::EpiOut, ep::SchedOut, true, true>(F.lds + RING_OFF, g, S, E);
    }
#undef IN
#undef BOTH
#undef GRID_BAR
}

extern "C" void kernel_launch(void* const* d_in, const int* in_sizes, int n_in, void* d_out, int out_size, void* d_ws, size_t ws_size, hipStream_t stream) {
    static int grid = 0;
    if (grid == 0) {
        if (n_in != 25 || ws_size < WS_END || out_size != R * 1024) { fprintf(stderr, "kernel_launch: bad args n_in %d ws %zu out %d\n", n_in, ws_size, out_size); grid = -1; return; }
        int dev = 0, cus = 0, per_cu = 0;
        if (hipGetDevice(&dev) != hipSuccess || hipDeviceGetAttribute(&cus, hipDeviceAttributeMultiprocessorCount, dev) != hipSuccess) { grid = -1; return; }
        if (hipFuncSetAttribute((const void*)skel_fwd, hipFuncAttributeMaxDynamicSharedMemorySize, LDS_BYTES) != hipSuccess) { fprintf(stderr, "hipFuncSetAttribute failed\n"); grid = -1; return; }
        if (hipOccupancyMaxActiveBlocksPerMultiprocessor(&per_cu, (const void*)skel_fwd, NWAVES * 64, LDS_BYTES) != hipSuccess || per_cu < 1) { fprintf(stderr, "occupancy query: %d blocks per CU\n", per_cu); grid = -1; (void)hipGetLastError(); return; }
        grid = cus;
    }
    if (grid < 0) return;
    if (hipMemsetAsync((char*)d_ws + WS_CTL, 0, CTL_ZERO_BYTES, stream) != hipSuccess) return;
    Args a{};
    const float** pp = (const float**)&a.p;
    for (int i = 0; i < 25; ++i) pp[i] = (const float*)d_in[i];
    a.p.out = (float*)d_out; a.p.ws = (unsigned char*)d_ws;
    const P& p = a.p;
    a.ph_lo = 0; a.ph_hi = 8; a.li = 0;
    hipLaunchKernelGGL(skel_fwd, dim3(grid), dim3(NWAVES * 64), LDS_BYTES, stream, a);
}
```
